# Optimizing an MI355X kernel written in HIP

```python
import math
import jax, jax.numpy as jnp
from jax import lax
import numpy as np

D_MODEL = 2048
BATCH = 2
SEQ = 16384
DEPTH = 1
DEC_BATCH = 16
DEC_SEQ = 64
PAST_LEN = 2048

CHUNK = 64
MLP_WIDTH = D_MODEL // 2
ATTN_WIDTH = D_MODEL - MLP_WIDTH
MLP_GROUPS = 8
MLP_GROUP_DIM = MLP_WIDTH // MLP_GROUPS
MLP_CHUNK = 128
N_HEADS = 8
HEAD_DIM = ATTN_WIDTH // (2 * N_HEADS)
V_HEAD_DIM = 2 * HEAD_DIM
QK_WIDTH = N_HEADS * 2 * HEAD_DIM
V_WIDTH = N_HEADS * V_HEAD_DIM
IN_WIDTH = 2 * MLP_WIDTH + 2 * QK_WIDTH + V_WIDTH
D_FF = ((8 * D_MODEL // 3 + 255) // 256) * 256
N_BUCKETS = 32
MAX_DISTANCE = 128
Q_BLOCK = 128
EPS = 1e-6

kernel_name = 'hybrid_gmlp_diffattn_stream_step'


def rmsnorm(x, g):
    xf = x.astype(jnp.float32)
    y = xf * lax.rsqrt(jnp.mean(xf * xf, axis=-1, keepdims=True) + EPS)
    return (y * g.astype(jnp.float32)).astype(x.dtype)


def layernorm(x, g, b):
    xf = x.astype(jnp.float32)
    mu = jnp.mean(xf, axis=-1, keepdims=True)
    var = jnp.mean(jnp.square(xf - mu), axis=-1, keepdims=True)
    y = (xf - mu) * lax.rsqrt(var + EPS)
    return (y * g.astype(jnp.float32) + b.astype(jnp.float32)).astype(x.dtype)


def modulate(h, shift, scale):
    return h * (1 + scale[:, None, :]) + shift[:, None, :]


def adaln(c, w, b, n):
    m = jnp.einsum('bd,de->be', jax.nn.silu(c), w) + b
    return jnp.split(m, n, axis=-1)


def t5_bucket(rel):
    nb = N_BUCKETS // 2
    max_exact = nb // 2
    ret = jnp.where(rel > 0, nb, 0)
    n = jnp.abs(rel)
    nf = jnp.maximum(n, 1).astype(jnp.float32)
    large = max_exact + (jnp.log(nf / max_exact) / math.log(MAX_DISTANCE / max_exact)
                         * (nb - max_exact)).astype(jnp.int32)
    large = jnp.minimum(large, nb - 1)
    return ret + jnp.where(n < max_exact, n, large)


def diff_attention(q, k, v, q_pos, k_pos, lam, rel_bias):
    bias = jnp.transpose(rel_bias[t5_bucket(k_pos[None, :] - q_pos[:, None])], (2, 0, 1)).astype(jnp.float32)
    allowed = (k_pos[None, :] // CHUNK) <= (q_pos[:, None] // CHUNK)
    logits = jnp.einsum('bqhtd,bkhtd->bthqk', q, k).astype(jnp.float32) * (HEAD_DIM ** -0.5) + bias[None, None]
    logits = jnp.where(allowed[None, None, None], logits, -jnp.inf)
    probs = jax.nn.softmax(logits, axis=-1)
    attn = probs[:, 0] - lam * probs[:, 1]
    return jnp.einsum('bhqk,bkhd->bqhd', attn.astype(v.dtype), v)


def prompt_attention(q, k, v, pos, lam, rel_bias):
    B, S = q.shape[:2]
    nb = S // Q_BLOCK
    qb = jnp.swapaxes(q.reshape(B, nb, Q_BLOCK, N_HEADS, 2, HEAD_DIM), 0, 1)
    pb = pos.reshape(nb, Q_BLOCK)
    out = lax.map(lambda a: diff_attention(a[0], k, v, a[1], pos, lam, rel_bias), (qb, pb))
    return jnp.swapaxes(out, 0, 1).reshape(B, S, N_HEADS, V_HEAD_DIM)


def diff_lambda(lq1, lk1, lq2, lk2, lam_init):
    f = jnp.float32
    return (jnp.exp(jnp.sum(lq1.astype(f) * lk1.astype(f))) -
            jnp.exp(jnp.sum(lq2.astype(f) * lk2.astype(f))) + lam_init)


def mixer_in(x, shift, scale, g_norm, w_in, ln_g, ln_b):
    B, S = x.shape[:2]
    h = modulate(rmsnorm(x, g_norm), shift, scale)
    z = jnp.einsum('bsd,de->bse', h, w_in)
    o1 = MLP_WIDTH
    o2 = 2 * MLP_WIDTH
    o3 = o2 + QK_WIDTH
    o4 = o3 + QK_WIDTH
    u = jax.nn.gelu(z[..., :o1])
    gv = layernorm(jax.nn.gelu(z[..., o1:o2]), ln_g, ln_b)
    q = z[..., o2:o3].reshape(B, S, N_HEADS, 2, HEAD_DIM)
    k = z[..., o3:o4].reshape(B, S, N_HEADS, 2, HEAD_DIM)
    v = z[..., o4:].reshape(B, S, N_HEADS, V_HEAD_DIM)
    return u, gv, q, k, v


def spatial_gate(u, gv, w_s, b_s):
    T = u.shape[2]
    idx = jnp.arange(T)
    mask = (idx[None, :] // CHUNK) <= (idx[:, None] // CHUNK)
    w = jnp.where(mask[None], w_s[:, :T, :T], 0)
    mixed = jnp.einsum('gij,bnjgc->bnigc', w, gv) + jnp.transpose(b_s[:, :T])[None, None, :, :, None]
    return u * mixed


def mixer_out(x, m, a, gate, sub_g, lam_init, w_out):
    B, S = x.shape[:2]
    a = rmsnorm(a, sub_g) * (1 - lam_init)
    cat = jnp.concatenate([m.reshape(B, S, MLP_WIDTH), a.reshape(B, S, ATTN_WIDTH)], axis=-1)
    return x + gate[:, None, :] * jnp.einsum('bse,ed->bsd', cat, w_out)


def ffn_sublayer(x, shift, scale, gate, g_norm, w_ffn_in, w_ffn_out):
    h = modulate(rmsnorm(x, g_norm), shift, scale)
    zg, zu = jnp.split(jnp.einsum('bsd,df->bsf', h, w_ffn_in), 2, axis=-1)
    return x + gate[:, None, :] * jnp.einsum('bsf,fd->bsd', jax.nn.silu(zg) * zu, w_ffn_out)


def setup_inputs(seed: int = 0) -> dict:
    key = jax.random.key(seed)
    ks = jax.random.split(key, 32)
    f = jnp.float32
    nrm = lambda k, s, sc: jax.random.normal(k, s, f) * sc
    D = D_MODEL
    return {
        'x_prompt': nrm(ks[0], (BATCH, SEQ, D), 1.0),
        'x_sample': nrm(ks[1], (DEC_BATCH, DEC_SEQ, D), 1.0),
        'cache_k': nrm(ks[2], (DEPTH, DEC_BATCH, PAST_LEN, N_HEADS, 2 * HEAD_DIM), 1.0),
        'cache_v': nrm(ks[3], (DEPTH, DEC_BATCH, PAST_LEN, N_HEADS, V_HEAD_DIM), 1.0),
        'c_prompt': nrm(ks[4], (BATCH, D), 1.0),
        'c_sample': nrm(ks[5], (DEC_BATCH, D), 1.0),
        'rel_bias': nrm(ks[6], (N_BUCKETS, N_HEADS), 0.5),
        'w_ada': nrm(ks[7], (DEPTH, D, 6 * D), 0.5 * D ** -0.5),
        'b_ada': nrm(ks[8], (DEPTH, 6 * D), 0.01),
        'w_ada_final': nrm(ks[9], (D, 2 * D), 0.5 * D ** -0.5),
        'b_ada_final': nrm(ks[10], (2 * D,), 0.01),
        'g_mix': 1.0 + nrm(ks[11], (DEPTH, D), 0.01),
        'g_ffn': 1.0 + nrm(ks[12], (DEPTH, D), 0.01),
        'g_final': 1.0 + nrm(ks[13], (D,), 0.01),
        'w_in': nrm(ks[14], (DEPTH, D, IN_WIDTH), D ** -0.5),
        'mlp_ln_g': 1.0 + nrm(ks[15], (DEPTH, MLP_WIDTH), 0.01),
        'mlp_ln_b': nrm(ks[16], (DEPTH, MLP_WIDTH), 0.01),
        'w_s': nrm(ks[17], (DEPTH, MLP_GROUPS, MLP_CHUNK, MLP_CHUNK), MLP_CHUNK ** -0.5),
        'b_s': 1.0 + nrm(ks[18], (DEPTH, MLP_GROUPS, MLP_CHUNK), 0.01),
        'lambda_q1': nrm(ks[19], (DEPTH, HEAD_DIM), 0.1),
        'lambda_k1': nrm(ks[20], (DEPTH, HEAD_DIM), 0.1),
        'lambda_q2': nrm(ks[21], (DEPTH, HEAD_DIM), 0.1),
        'lambda_k2': nrm(ks[22], (DEPTH, HEAD_DIM), 0.1),
        'sub_g': 1.0 + nrm(ks[23], (DEPTH, V_HEAD_DIM), 0.01),
        'w_out': nrm(ks[24], (DEPTH, D, D), D ** -0.5),
        'w_ffn_in': nrm(ks[25], (DEPTH, D, 2 * D_FF), D ** -0.5),
        'w_ffn_out': nrm(ks[26], (DEPTH, D_FF, D), D_FF ** -0.5),
    }


def reference(x_prompt, x_sample, cache_k, cache_v, c_prompt, c_sample, rel_bias,
              w_ada, b_ada, w_ada_final, b_ada_final, g_mix, g_ffn, g_final,
              w_in, mlp_ln_g, mlp_ln_b, w_s, b_s, lambda_q1, lambda_k1, lambda_q2, lambda_k2,
              sub_g, w_out, w_ffn_in, w_ffn_out):
    B, S, _ = x_prompt.shape
    DB, T, _ = x_sample.shape
    nc = S // MLP_CHUNK
    pos_p = jnp.arange(S, dtype=jnp.int32)
    q_pos_s = PAST_LEN + jnp.arange(T, dtype=jnp.int32)
    k_pos_s = jnp.arange(PAST_LEN + T, dtype=jnp.int32)
    xp, xs = x_prompt, x_sample
    kp_rows, vp_rows, ks_rows, vs_rows, gvs_rows = [], [], [], [], []
    for l in range(DEPTH):
        lam_init = 0.8 - 0.6 * math.exp(-0.3 * l)
        lam = diff_lambda(lambda_q1[l], lambda_k1[l], lambda_q2[l], lambda_k2[l], lam_init)

        sh1, sc1, gt1, sh2, sc2, gt2 = adaln(c_prompt, w_ada[l], b_ada[l], 6)
        u, gv, q, k, v = mixer_in(xp, sh1, sc1, g_mix[l], w_in[l], mlp_ln_g[l], mlp_ln_b[l])
        m = spatial_gate(u.reshape(B, nc, MLP_CHUNK, MLP_GROUPS, MLP_GROUP_DIM),
                         gv.reshape(B, nc, MLP_CHUNK, MLP_GROUPS, MLP_GROUP_DIM), w_s[l], b_s[l])
        a = prompt_attention(q, k, v, pos_p, lam, rel_bias)
        xp = mixer_out(xp, m, a, gt1, sub_g[l], lam_init, w_out[l])
        xp = ffn_sublayer(xp, sh2, sc2, gt2, g_ffn[l], w_ffn_in[l], w_ffn_out[l])
        kp_rows.append(k.reshape(B, S, N_HEADS, 2 * HEAD_DIM))
        vp_rows.append(v)

        sh1, sc1, gt1, sh2, sc2, gt2 = adaln(c_sample, w_ada[l], b_ada[l], 6)
        u, gv, q, k, v = mixer_in(xs, sh1, sc1, g_mix[l], w_in[l], mlp_ln_g[l], mlp_ln_b[l])
        gv_s = gv.reshape(DB, T, MLP_GROUPS, MLP_GROUP_DIM)
        m = spatial_gate(u.reshape(DB, 1, T, MLP_GROUPS, MLP_GROUP_DIM), gv_s[:, None], w_s[l], b_s[l])
        k_all = jnp.concatenate([cache_k[l].reshape(DB, PAST_LEN, N_HEADS, 2, HEAD_DIM), k], axis=1)
        v_all = jnp.concatenate([cache_v[l], v], axis=1)
        a = diff_attention(q, k_all, v_all, q_pos_s, k_pos_s, lam, rel_bias)
        xs = mixer_out(xs, m, a, gt1, sub_g[l], lam_init, w_out[l])
        xs = ffn_sublayer(xs, sh2, sc2, gt2, g_ffn[l], w_ffn_in[l], w_ffn_out[l])
        ks_rows.append(k.reshape(DB, T, N_HEADS, 2 * HEAD_DIM))
        vs_rows.append(v)
        gvs_rows.append(gv_s)

    shp, scp = adaln(c_prompt, w_ada_final, b_ada_final, 2)
    shs, scs = adaln(c_sample, w_ada_final, b_ada_final, 2)
    y_prompt = modulate(rmsnorm(xp, g_final), shp, scp)
    y_sample = modulate(rmsnorm(xs, g_final), shs, scs)
    new_k_prompt = jnp.stack(kp_rows)
    new_v_prompt = jnp.stack(vp_rows)
    new_k_sample = jnp.stack(ks_rows)
    new_v_sample = jnp.stack(vs_rows)
    new_gv_sample = jnp.stack(gvs_rows)
    return (y_prompt, y_sample, new_k_prompt, new_v_prompt, new_k_sample, new_v_sample, new_gv_sample)
```

```cpp
#include <hip/hip_runtime.h>
#include <hip/hip_bf16.h>
#include <hip/hip_cooperative_groups.h>
#include <cstdio>
#include <cstdint>
#include <cmath>
namespace cg = cooperative_groups;
#ifndef PROBE_REP
#define PROBE_REP 0
#endif
__device__ __forceinline__ int opaque_i(int v) { asm volatile("" : "+s"(v)); return v; }
__device__ __forceinline__ int fresh_lane() { int l; asm volatile("v_mbcnt_lo_u32_b32 %0, -1, 0\n\tv_mbcnt_hi_u32_b32 %0, -1, %0" : "=v"(l)); return l; }
namespace pg8 {
#define PG8_LAS __attribute__((address_space(3)))
typedef unsigned short bf16_t;
typedef short bf16x8 __attribute__((ext_vector_type(8)));
typedef float f32x4 __attribute__((ext_vector_type(4)));
typedef unsigned u32x4 __attribute__((ext_vector_type(4)));
constexpr int BM = 256, BK = 64, HALF = 128, HTB = HALF * BK * 2  , STAGE_BYTES = 8 * HTB, NXCD = 8, WGM = 8;

__host__ __device__ __forceinline__ int lds_byte(int r, int c) { const int st = (r >> 4) * 2 + (c >> 5), rr = r & 15, cc = c & 31, ob = rr * 64 + cc * 2; return st * 1024 + (ob ^ (((ob >> 9) & 1) << 5)); }
__host__ __device__ __forceinline__ void stage_rc(int b, int& R, int& C) { const int st = b / 1024, sb = b % 1024, swz = sb ^ (((sb >> 9) & 1) << 5); R = (st >> 1) * 16 + swz / 64; C = (st & 1) * 32 + (swz % 64) / 2; }
__host__ __device__ __forceinline__ int perm32(int rho) { const int n = rho >> 4, i = rho & 15; return 8 * (i >> 2) + 4 * n + (i & 3); }

struct Unit { int pm, pn, k0, nt, split; };
struct Gemm { const bf16_t* A; const bf16_t* Bt; int M, N, K; };

struct StaticOrder {
    int nM, nN, nwg, G, c, rep, ntk, nsplit, nMmain;
    __host__ __device__ void init(int M, int N, int K, int G_, int c_, int rep_ = 1, int nsplit_ = 0) { nM = M / BM; nN = N / BM; G = G_; c = c_; rep = rep_; ntk = K / BK; nsplit = nsplit_;
        nMmain = nsplit_ > 0 ? 128 : nM; nwg = nMmain * nN; }
    __host__ __device__ bool next(int i, Unit& u) const {
        const long L = (long)i * G + c; u.k0 = 0; u.nt = ntk; u.split = 0;
        if (nsplit > 0 && L >= nwg) { const int s = (int)(L - nwg); if (s >= (nM - nMmain) * nN * nsplit) return false;
            const int tile = s / nsplit, ks = s % nsplit; u.pm = nMmain + tile / nN; u.pn = tile % nN; u.nt = ntk / nsplit; u.k0 = ks * u.nt; u.split = 1; return true; }
        if (L >= (long)nwg * rep) return false;
        int wgid = (int)(L % nwg); { const int q = nwg / NXCD, r = nwg % NXCD, xcd = wgid % NXCD, off = wgid / NXCD; wgid = (xcd < r ? xcd * (q + 1) : r * (q + 1) + (xcd - r) * q) + off; }
        const int nig = WGM * nN, gid = wgid / nig, fm = gid * WGM, gsz = (nMmain - fm) < WGM ? (nMmain - fm) : WGM;
        u.pm = fm + ((wgid % nig) % gsz); u.pn = (wgid % nig) / gsz; return true;
    }
    __device__ __forceinline__ void a_ready(const Unit&) const {}
    __device__ __forceinline__ void done(const Unit&) const {}
};

__device__ __forceinline__ unsigned cvt_pk_bf16(float lo, float hi) { unsigned r; asm volatile("v_cvt_pk_bf16_f32 %0, %1, %2" : "=v"(r) : "v"(lo), "v"(hi)); return r; }
typedef float f32x2 __attribute__((ext_vector_type(2)));
constexpr int MROWS = 33792, MP = 32768;
constexpr long OUT_Y = 0, OUT_KP = 69206016L, OUT_VP = 102760448L, OUT_KS = 136314880L, OUT_VS = 137363456L, OUT_GVS = 138412032L;
__device__ __forceinline__ int row_batch(int row) { return row < MP ? (row >> 14) : 2 + ((row - MP) >> 6); }
__device__ __forceinline__ float gelu_tanh(float x) { const float u = 0.7978845608028654f * (x + 0.044715f * x * x * x); const float e = __builtin_amdgcn_exp2f(-2.8853900817779268f * u); return x * __builtin_amdgcn_rcpf(1.0f + e); }
__device__ __forceinline__ float silu_f(float x) { const float e = __builtin_amdgcn_exp2f(-1.4426950408889634f * x); return x * __builtin_amdgcn_rcpf(1.0f + e); }
__device__ __forceinline__ u32x4 pack8(f32x4 v0, f32x4 v1) { u32x4 w; w.x = cvt_pk_bf16(v0[0], v0[1]); w.y = cvt_pk_bf16(v0[2], v0[3]); w.z = cvt_pk_bf16(v1[0], v1[1]); w.w = cvt_pk_bf16(v1[2], v1[3]); return w; }

struct EpiIn {
    static constexpr bool PERM = true, AFTER_DRAIN = false;
    bf16_t *U, *G, *Q, *Kb, *Vb; float* out;
    __device__ __forceinline__ void operator()(const f32x4 (&acc)[2][2][4][2], const Unit& u, int wr, int wc, int fr, int fq) const {
        const int seg = u.pn >> 2, colt = (u.pn & 3) * BM;
        const int row0 = u.pm * BM + wr * 64 + fr, col0 = colt + wc * 32 + 8 * fq;
        bf16_t* dst = seg == 0 ? U : seg == 1 ? G : seg == 2 ? Q : seg == 3 ? Kb : Vb;
#pragma unroll
        for (int ai = 0; ai < 2; ++ai)
#pragma unroll
            for (int m = 0; m < 4; ++m) { const int row = row0 + ai * HALF + m * 16;
#pragma unroll
                for (int bj = 0; bj < 2; ++bj) { f32x4 v0 = acc[ai][bj][m][0], v1 = acc[ai][bj][m][1]; const int col = col0 + bj * HALF;
                    if (seg < 2) {
#pragma unroll
                        for (int e = 0; e < 4; ++e) { v0[e] = gelu_tanh(v0[e]); v1[e] = gelu_tanh(v1[e]); }
                    } else if (seg == 2) { v0 = v0 * 0.18033688011112042f; v1 = v1 * 0.18033688011112042f; }
                    else { float* o = (row < MP) ? out + (seg == 3 ? OUT_KP : OUT_VP) + (size_t)row * 1024 + col : out + (seg == 3 ? OUT_KS : OUT_VS) + (size_t)(row - MP) * 1024 + col;
                        *(f32x4*)o = v0; *(f32x4*)(o + 4) = v1; }
                    *(u32x4*)(dst + (size_t)row * 1024 + col) = pack8(v0, v1); } }
    }
};
struct EpiRes {
    static constexpr bool PERM = true, AFTER_DRAIN = false;
    const float* xp; const bf16_t* baseb; bf16_t* outb; const float* gate; float* part;
    __device__ __forceinline__ void operator()(const f32x4 (&acc)[2][2][4][2], const Unit& u, int wr, int wc, int fr, int fq) const {
        const int row0 = u.pm * BM + wr * 64 + fr, col0 = u.pn * BM + wc * 32 + 8 * fq;
#pragma unroll
        for (int ai = 0; ai < 2; ++ai) {
            const int b = row_batch(u.pm * BM + ai * HALF + wr * 64);
            const float* gt = gate + (size_t)b * 12288 + col0;
            f32x4 g[2][2];
#pragma unroll
            for (int bj = 0; bj < 2; ++bj) { g[bj][0] = *(const f32x4*)(gt + bj * HALF); g[bj][1] = *(const f32x4*)(gt + bj * HALF + 4); }
#pragma unroll
            for (int m = 0; m < 4; ++m) { const int row = row0 + ai * HALF + m * 16;
#pragma unroll
                for (int bj = 0; bj < 2; ++bj) { const int col = col0 + bj * HALF;
                    if (u.split) { float* pp = part + ((size_t)(u.k0 / u.nt) * (MROWS - MP) + (size_t)(row - MP)) * 2048 + col;
                        *(f32x4*)pp = g[bj][0] * acc[ai][bj][m][0]; *(f32x4*)(pp + 4) = g[bj][1] * acc[ai][bj][m][1];
                    } else {
                        f32x4 b0, b1;
                        if (xp) { const float* src = xp + (size_t)row * 2048 + col; b0 = *(const f32x4*)src; b1 = *(const f32x4*)(src + 4); }
                        else { const u32x4 w = *(const u32x4*)(baseb + (size_t)row * 2048 + col);
                            b0 = (f32x4){__builtin_bit_cast(float, w.x << 16), __builtin_bit_cast(float, w.x & 0xffff0000u), __builtin_bit_cast(float, w.y << 16), __builtin_bit_cast(float, w.y & 0xffff0000u)};
                            b1 = (f32x4){__builtin_bit_cast(float, w.z << 16), __builtin_bit_cast(float, w.z & 0xffff0000u), __builtin_bit_cast(float, w.w << 16), __builtin_bit_cast(float, w.w & 0xffff0000u)}; }
                        *(u32x4*)(outb + (size_t)row * 2048 + col) = pack8(b0 + g[bj][0] * acc[ai][bj][m][0], b1 + g[bj][1] * acc[ai][bj][m][1]); } } }
        }
    }
};
struct EpiGlu {
    static constexpr bool PERM = true, AFTER_DRAIN = false;
    bf16_t* F;
    __device__ __forceinline__ void operator()(const f32x4 (&acc)[2][2][4][2], const Unit& u, int wr, int wc, int fr, int fq) const {
        const int row0 = u.pm * BM + wr * 64 + fr, col0 = u.pn * HALF + wc * 32 + 8 * fq;
#pragma unroll
        for (int ai = 0; ai < 2; ++ai)
#pragma unroll
            for (int m = 0; m < 4; ++m) { const int row = row0 + ai * HALF + m * 16;
                f32x4 v0, v1;
#pragma unroll
                for (int e = 0; e < 4; ++e) { v0[e] = silu_f(acc[ai][0][m][0][e]) * acc[ai][1][m][0][e]; v1[e] = silu_f(acc[ai][0][m][1][e]) * acc[ai][1][m][1][e]; }
                *(u32x4*)(F + (size_t)row * 5632 + col0) = pack8(v0, v1); }
    }
};

template <class Epi, class Sched, bool ALIGN_EPI = false, bool SP2 = false>
__device__ __forceinline__ void gemm_phase(PG8_LAS unsigned char* lds, const Gemm g, const Sched& S, const Epi& E, const int wid_in) {
    const int wid = wid_in, lane = fresh_lane(), tid = wid * 64 + lane, wr = wid >> 2, wc = wid & 3, fr = lane & 15, fq = lane >> 4;
    const int K = g.K;
    unsigned voffA[2], voffB[2];
#pragma unroll
    for (int i = 0; i < 2; ++i) { int R, C; stage_rc(tid * 16 + i * 8192, R, C); const int Rb = Epi::PERM ? ((R & ~31) + perm32(R & 31)) : R;
        voffA[i] = (unsigned)(R * K + C) * 2u; voffB[i] = (unsigned)(Rb * K + C) * 2u; }
    const size_t kstep = (size_t)(BK * 2);
    const size_t hstep = (size_t)HALF * K * 2;
    const size_t tstep = 2 * hstep;
    const unsigned ldsw = (unsigned)wid * 1024u;
    const int aoff = lds_byte(wr * 64 + fr, fq * 8), boff = lds_byte(wc * 32 + fr, fq * 8);
#define PG8_SA(b, h) (((b) * 2 + (h)) * HTB)
#define PG8_SB(b, h) ((4 + (b) * 2 + (h)) * HTB)
#define PG8_STAGE(bufoff, gbase, voff) do { _Pragma("unroll") for (int _i = 0; _i < 2; ++_i) \
        __builtin_amdgcn_global_load_lds((const unsigned*)((const char*)(gbase) + (voff)[_i]), (PG8_LAS unsigned*)(lds + (bufoff) + ldsw + _i * 8192), 16, 0, 0); } while (0)
#define PG8_LDA(dst, b, h) do { _Pragma("unroll") for (int m = 0; m < 4; ++m) _Pragma("unroll") for (int k = 0; k < 2; ++k) dst[m][k] = *(const PG8_LAS bf16x8*)(lds + PG8_SA(b, h) + aoff + m * 2048 + k * 1024); } while (0)
#define PG8_LDB(dst, b, h) do { _Pragma("unroll") for (int n = 0; n < 2; ++n) _Pragma("unroll") for (int k = 0; k < 2; ++k) dst[n][k] = *(const PG8_LAS bf16x8*)(lds + PG8_SB(b, h) + boff + n * 2048 + k * 1024); } while (0)
#define PG8_MMA(ai, bj, At, Bt) do { __builtin_amdgcn_s_setprio(1); _Pragma("unroll") for (int m = 0; m < 4; ++m) _Pragma("unroll") for (int n = 0; n < 2; ++n) _Pragma("unroll") for (int k = 0; k < 2; ++k) \
        acc[ai][bj][m][n] = __builtin_amdgcn_mfma_f32_16x16x32_bf16(Bt[n][k], At[m][k], acc[ai][bj][m][n], 0, 0, 0); __builtin_amdgcn_s_setprio(0); } while (0)
#define PG8_WAIT_V(n) asm volatile("s_waitcnt vmcnt(" #n ")" ::: "memory")
#define PG8_WAIT_L(n) asm volatile("s_waitcnt lgkmcnt(" #n ")" ::: "memory")
#define PG8_BAR __builtin_amdgcn_s_barrier()
#define PG8_SCHED __builtin_amdgcn_sched_barrier(0)
    Unit cur, nxt; int ui = 0;
    if (!S.next(0, cur)) return;
    f32x4 acc[2][2][4][2];
#pragma unroll
    for (int a = 0; a < 2; ++a)
#pragma unroll
        for (int b = 0; b < 2; ++b)
#pragma unroll
            for (int m = 0; m < 4; ++m)
#pragma unroll
                for (int n = 0; n < 2; ++n) acc[a][b][m][n] = (f32x4){0.f, 0.f, 0.f, 0.f};
    bf16x8 At[4][2], B0[2][2], B1[2][2];
    const char* cA = (const char*)g.A + (size_t)cur.pm * tstep + (size_t)cur.k0 * kstep; const char* cB = (const char*)g.Bt + (size_t)cur.pn * tstep + (size_t)cur.k0 * kstep;
    int nt = cur.nt;
    S.a_ready(cur);
    if constexpr (SP2) {
        PG8_STAGE(PG8_SB(0, 0), cB, voffB); PG8_STAGE(PG8_SB(0, 1), cB + hstep, voffB); PG8_STAGE(PG8_SA(0, 0), cA, voffA); PG8_STAGE(PG8_SA(0, 1), cA + hstep, voffA);
        if (wr == 1) PG8_BAR;
        PG8_WAIT_V(2); PG8_BAR;
        PG8_STAGE(PG8_SB(1, 0), cB + kstep, voffB); PG8_STAGE(PG8_SA(1, 0), cA + kstep, voffA); PG8_STAGE(PG8_SB(1, 1), cB + hstep + kstep, voffB);
        PG8_WAIT_V(6); PG8_BAR;
    } else {
        PG8_STAGE(PG8_SB(0, 0), cB, voffB); PG8_STAGE(PG8_SA(0, 0), cA, voffA); PG8_STAGE(PG8_SB(0, 1), cB + hstep, voffB); PG8_STAGE(PG8_SA(0, 1), cA + hstep, voffA);
        if (wr == 1) PG8_BAR;
        PG8_WAIT_V(4); PG8_BAR;
        PG8_STAGE(PG8_SB(1, 0), cB + kstep, voffB); PG8_STAGE(PG8_SA(1, 0), cA + kstep, voffA); PG8_STAGE(PG8_SB(1, 1), cB + hstep + kstep, voffB);
        PG8_WAIT_V(6); PG8_BAR;
    }
    for (;;) {
        const bool has_next = S.next(ui + 1, nxt);
        const char* nA = has_next ? (const char*)g.A + (size_t)nxt.pm * tstep + (size_t)nxt.k0 * kstep : cA; const char* nB = has_next ? (const char*)g.Bt + (size_t)nxt.pn * tstep + (size_t)nxt.k0 * kstep : cB;
        for (int t = 0; t < nt; t += 2) {
            const bool last = (t == nt - 2);
            const char* a1 = cA + (size_t)(t + 1) * kstep;
            const char* a2 = last ? nA : cA + (size_t)(t + 2) * kstep; const char* b2 = last ? nB : cB + (size_t)(t + 2) * kstep;
            const char* a3 = a2 + kstep; const char* b3 = b2 + kstep;
            if (last && has_next) S.a_ready(nxt);
            if constexpr (SP2) {
            PG8_LDB(B0, 0, 0); PG8_LDB(B1, 0, 1); PG8_SCHED; PG8_LDA(At, 0, 0); PG8_STAGE(PG8_SA(1, 1), a1 + hstep, voffA);
            PG8_WAIT_V(8); PG8_WAIT_L(0); PG8_BAR; PG8_MMA(0, 0, At, B0); PG8_MMA(0, 1, At, B1); PG8_BAR; PG8_SCHED;
            PG8_LDA(At, 0, 1); PG8_STAGE(PG8_SB(0, 0), b2, voffB); PG8_STAGE(PG8_SB(0, 1), b2 + hstep, voffB); PG8_STAGE(PG8_SA(0, 0), a2, voffA);
            PG8_WAIT_V(8); PG8_WAIT_L(0); PG8_BAR; PG8_MMA(1, 0, At, B0); PG8_MMA(1, 1, At, B1); PG8_BAR; PG8_SCHED;
            PG8_LDB(B0, 1, 0); PG8_LDB(B1, 1, 1); PG8_SCHED; PG8_LDA(At, 1, 0); PG8_STAGE(PG8_SA(0, 1), a2 + hstep, voffA);
            PG8_WAIT_V(8); PG8_WAIT_L(0); PG8_BAR; PG8_MMA(0, 0, At, B0); PG8_MMA(0, 1, At, B1); PG8_BAR; PG8_SCHED;
            PG8_LDA(At, 1, 1); PG8_STAGE(PG8_SB(1, 0), b3, voffB); PG8_STAGE(PG8_SB(1, 1), b3 + hstep, voffB); PG8_STAGE(PG8_SA(1, 0), a3, voffA);
            PG8_WAIT_V(8); PG8_WAIT_L(0); PG8_BAR; PG8_MMA(1, 0, At, B0); PG8_MMA(1, 1, At, B1); PG8_BAR; PG8_SCHED;
            } else {
            PG8_LDB(B0, 0, 0); PG8_SCHED; PG8_LDA(At, 0, 0); PG8_STAGE(PG8_SA(1, 1), a1 + hstep, voffA);
            PG8_WAIT_L(8); PG8_BAR; PG8_WAIT_L(0); PG8_MMA(0, 0, At, B0); PG8_BAR; PG8_SCHED;
            PG8_LDB(B1, 0, 1); PG8_STAGE(PG8_SB(0, 0), b2, voffB);
            PG8_BAR; PG8_WAIT_L(0); PG8_MMA(0, 1, At, B1); PG8_BAR;
            PG8_LDA(At, 0, 1); PG8_STAGE(PG8_SA(0, 0), a2, voffA);
            PG8_BAR; PG8_WAIT_L(0); PG8_MMA(1, 0, At, B0); PG8_BAR; PG8_SCHED;
            PG8_STAGE(PG8_SB(0, 1), b2 + hstep, voffB);
            PG8_WAIT_V(6); PG8_BAR; PG8_MMA(1, 1, At, B1); PG8_BAR;
            PG8_LDB(B0, 1, 0); PG8_SCHED; PG8_LDA(At, 1, 0); PG8_STAGE(PG8_SA(0, 1), a2 + hstep, voffA);
            PG8_WAIT_L(8); PG8_BAR; PG8_WAIT_L(0); PG8_MMA(0, 0, At, B0); PG8_BAR; PG8_SCHED;
            PG8_LDB(B1, 1, 1); PG8_STAGE(PG8_SB(1, 0), b3, voffB);
            PG8_BAR; PG8_WAIT_L(0); PG8_MMA(0, 1, At, B1); PG8_BAR;
            PG8_LDA(At, 1, 1); PG8_STAGE(PG8_SA(1, 0), a3, voffA);
            PG8_BAR; PG8_WAIT_L(0); PG8_MMA(1, 0, At, B0); PG8_BAR; PG8_SCHED;
            PG8_STAGE(PG8_SB(1, 1), b3 + hstep, voffB);
            PG8_WAIT_V(6); PG8_BAR; PG8_MMA(1, 1, At, B1); PG8_BAR;
            }
        }
        if constexpr (ALIGN_EPI) { if (wr == 0) PG8_BAR; }
        if constexpr (!Epi::AFTER_DRAIN) { E(acc, cur, wr, wc, fr, fq); S.done(cur); }
        if (!has_next) break;
#pragma unroll
        for (int a = 0; a < 2; ++a)
#pragma unroll
            for (int b = 0; b < 2; ++b)
#pragma unroll
                for (int m = 0; m < 4; ++m)
#pragma unroll
                    for (int n = 0; n < 2; ++n) acc[a][b][m][n] = (f32x4){0.f, 0.f, 0.f, 0.f};
        cur = nxt; cA = nA; cB = nB; ++ui; nt = cur.nt;
        if constexpr (ALIGN_EPI) { if (wr == 1) PG8_BAR; }
    }
    PG8_WAIT_V(0);
    if constexpr (!ALIGN_EPI) { if (wr == 0) PG8_BAR; }
    PG8_BAR;
    if constexpr (Epi::AFTER_DRAIN) { E.fused(acc, cur, wr, wc, fr, fq, lds, wid, lane); S.done(cur); }
#undef PG8_SA
#undef PG8_SB
#undef PG8_STAGE
#undef PG8_LDA
#undef PG8_LDB
#undef PG8_MMA
#undef PG8_WAIT_V
#undef PG8_WAIT_L
#undef PG8_BAR
#undef PG8_SCHED
}
}
namespace attn_body {
using bf16=__hip_bfloat16;
using bf16x8=__attribute__((ext_vector_type(8)))short;
using s16x4=__attribute__((ext_vector_type(4)))short;
using f32x16=__attribute__((ext_vector_type(16)))float;
using u32x4=__attribute__((ext_vector_type(4)))unsigned;
constexpr int BATCH=2,NHEAD=16,SEQ=16384,D=64,DM=NHEAD*D,ODM=2048;
constexpr int NW=8,NA=4,QBLK=32,QB=QBLK*NW,KVBLK=64,NQB=SEQ/QB;
constexpr int ATTN_PITCH=DM, ATTN_UNIT_ROWS=QB;
__device__ __forceinline__ int crow(int r,int hi){return (r&3)+8*(r>>2)+4*hi;}
#define SBAR() __builtin_amdgcn_sched_barrier(0)
typedef __attribute__((address_space(3))) const float* lds_cfptr;
#ifndef CM_VAR
#define CM_VAR 0
#endif
#ifndef CM_GRP
#define CM_GRP 16
#endif
__device__ __forceinline__ int med3i(int a,int lo,int hi){ return a<lo?lo:(a>hi?hi:a); }
__device__ __forceinline__ void cmask(f32x16&p0,f32x16&p1,int jb,int qrel,int hi,lds_cfptr bt){
  const float NEG=-INFINITY;
#if CM_VAR==0
  const int kb=64*jb+4*hi; const int qlim=(qrel|63)-kb; const int base=kb-qrel+128;
  #pragma unroll
  for(int r=0;r<16;++r){const int ko=(r&3)+8*(r>>2);
    const float b0=bt[med3i(base+ko,0,192)], b1=bt[med3i(base+ko+32,0,192)];
    p0[r]=(ko>qlim)?NEG:p0[r]+b0; p1[r]=(ko+32>qlim)?NEG:p1[r]+b1;
    if((r%CM_GRP)==CM_GRP-1)__builtin_amdgcn_sched_barrier(0); }
#elif CM_VAR==1
  int kb=64*jb+4*hi; const int ql=qrel|63;
  #pragma unroll
  for(int r=0;r<16;++r){int kv=kb+(r&3)+8*(r>>2); if(kv>ql)p0[r]=NEG; if(kv+32>ql)p1[r]=NEG;}
#elif CM_VAR==2
  lds_cfptr bp = bt + (64*jb+4*hi-qrel+320); const int qlim=(qrel|63)-(64*jb+4*hi);
  #pragma unroll
  for(int r=0;r<16;++r){const int ko=(r&3)+8*(r>>2);
    const float b0=bp[ko], b1=bp[ko+32];
    p0[r]=(ko>qlim)?NEG:p0[r]+b0; p1[r]=(ko+32>qlim)?NEG:p1[r]+b1;
    if((r&3)==3)__builtin_amdgcn_sched_barrier(0); }
#endif
}

constexpr int NSLOT=3, SLOTB=8192;
constexpr int VSLOTB=2*SLOTB;
constexpr int NVSLOT=4;
constexpr int LDS_K=0, LDS_V=NSLOT*SLOTB, LDS_WS=LDS_V+NVSLOT*VSLOTB, LDS_BYTES=LDS_WS+NW*64*4;
constexpr float C2=0.125f*1.4426950408889634f;
__device__ __forceinline__ void glds16(const void*gsrc,unsigned lds_dst){unsigned keep;
  asm volatile("s_mov_b32 %0, m0\n\ts_mov_b32 m0, %2\n\ts_nop 0\n\tglobal_load_lds_dwordx4 %1, off\n\ts_mov_b32 m0, %0":"=&s"(keep):"v"(gsrc),"s"(lds_dst):"memory");}
__device__ __forceinline__ float max3f(float a,float b,float c){float r;asm("v_max3_f32 %0, %1, %2, %3":"=v"(r):"v"(a),"v"(b),"v"(c));return r;}
__device__ __forceinline__ float max2f(float a,float b){float r;asm("v_max_f32_e32 %0, %1, %2":"=v"(r):"v"(a),"v"(b));return r;}
__device__ __forceinline__ float fadd_s(float a,float b){float r;asm("v_add_f32_e32 %0, %1, %2":"=v"(r):"v"(a),"v"(b));return r;}
__device__ __forceinline__ float fsub_s(float a,float b){float r;asm("v_sub_f32_e32 %0, %1, %2":"=v"(r):"v"(a),"v"(b));return r;}
typedef float f32x2_t __attribute__((ext_vector_type(2))); typedef __bf16 bf16x2_t __attribute__((ext_vector_type(2)));
__device__ __forceinline__ unsigned cvtpk_s(float lo,float hi){f32x2_t v={lo,hi};bf16x2_t b=__builtin_convertvector(v,bf16x2_t);return __builtin_bit_cast(unsigned,b);}
#define WAIT_BAR(N) asm volatile("s_waitcnt vmcnt(" #N ") lgkmcnt(0)\n\ts_barrier":::"memory")

__device__ __forceinline__ void qkt(f32x16&p0,f32x16&p1,const char*Kslot,const bf16x8*qr,const f32x16&negm,int r32,int hi){
  const char*kb=Kslot+hi*1024+r32*16;
  #pragma unroll
  for(int d0=0;d0<4;++d0){
    const bf16x8 b0=*reinterpret_cast<const bf16x8*>(kb+d0*2048);
    const bf16x8 b1=*reinterpret_cast<const bf16x8*>(kb+d0*2048+512);
    if(d0==0){p0=__builtin_amdgcn_mfma_f32_32x32x16_bf16(b0,qr[0],negm,0,0,0);p1=__builtin_amdgcn_mfma_f32_32x32x16_bf16(b1,qr[0],negm,0,0,0);}
    else{p0=__builtin_amdgcn_mfma_f32_32x32x16_bf16(b0,qr[d0],p0,0,0,0);p1=__builtin_amdgcn_mfma_f32_32x32x16_bf16(b1,qr[d0],p1,0,0,0);}}
}
typedef __attribute__((address_space(3))) const char* lds_cptr;
typedef short v4i16_t __attribute__((ext_vector_type(4)));
__device__ __forceinline__ void kload8(bf16x8*kf,lds_cptr kp){
  kf[0]=*(const __attribute__((address_space(3))) bf16x8*)(kp);      kf[1]=*(const __attribute__((address_space(3))) bf16x8*)(kp+512);
  kf[2]=*(const __attribute__((address_space(3))) bf16x8*)(kp+2048); kf[3]=*(const __attribute__((address_space(3))) bf16x8*)(kp+2560);
  kf[4]=*(const __attribute__((address_space(3))) bf16x8*)(kp+4096); kf[5]=*(const __attribute__((address_space(3))) bf16x8*)(kp+4608);
  kf[6]=*(const __attribute__((address_space(3))) bf16x8*)(kp+6144); kf[7]=*(const __attribute__((address_space(3))) bf16x8*)(kp+6656);
}
__device__ __forceinline__ void kload2(bf16x8*kf,lds_cptr kp,int j){ kf[2*j]=*(const __attribute__((address_space(3))) bf16x8*)(kp+j*2048); kf[2*j+1]=*(const __attribute__((address_space(3))) bf16x8*)(kp+j*2048+512); }
__device__ __forceinline__ s16x4 vtr(lds_cptr p){ return __builtin_bit_cast(s16x4,__builtin_amdgcn_ds_read_tr16_b64_v4i16((__attribute__((address_space(3))) v4i16_t*)p)); }
__device__ __forceinline__ float rowmax(const f32x16&p0,const f32x16&p1){
  float a=max3f(p0[0],p0[1],p1[0]),b=max3f(p0[2],p0[3],p1[1]);a=max3f(a,p1[2],p1[3]);
  #pragma unroll
  for(int r=4;r<16;r+=4){a=max3f(a,p0[r],p0[r+1]);b=max3f(b,p0[r+2],p0[r+3]);a=max3f(a,p1[r],p1[r+1]);b=max3f(b,p1[r+2],p1[r+3]);}
  const float m=max2f(a,b);
  auto rr=__builtin_amdgcn_permlane32_swap(__float_as_uint(m),__float_as_uint(m),false,false);
  return max2f(__uint_as_float(rr[0]),__uint_as_float(rr[1]));
}
__device__ __forceinline__ void pv(f32x16*o,int vb,bf16x8 pa0,bf16x8 pa1,bf16x8 pa2,bf16x8 pa3){
  #pragma unroll
  for(int d0=0;d0<2;++d0){s16x4 lo[4],hi[4];
    #pragma unroll
    for(int ks=0;ks<4;++ks){
      asm volatile("ds_read_b64_tr_b16 %0,%1 offset:%c2":"=&v"(lo[ks]):"v"(vb),"i"(d0*4096+ks*1024):"memory");
      asm volatile("ds_read_b64_tr_b16 %0,%1 offset:%c2":"=&v"(hi[ks]):"v"(vb),"i"(d0*4096+ks*1024+512):"memory");}
    asm volatile("s_waitcnt lgkmcnt(0)":::"memory");SBAR();
    #define PK(k) (bf16x8){lo[k][0],lo[k][1],lo[k][2],lo[k][3],hi[k][0],hi[k][1],hi[k][2],hi[k][3]}
    o[d0]=__builtin_amdgcn_mfma_f32_32x32x16_bf16(pa0,PK(0),o[d0],0,0,0);
    o[d0]=__builtin_amdgcn_mfma_f32_32x32x16_bf16(pa1,PK(1),o[d0],0,0,0);
    o[d0]=__builtin_amdgcn_mfma_f32_32x32x16_bf16(pa2,PK(2),o[d0],0,0,0);
    o[d0]=__builtin_amdgcn_mfma_f32_32x32x16_bf16(pa3,PK(3),o[d0],0,0,0);
    #undef PK
  }
}

__device__ __forceinline__ void pv4(f32x16*o,int vb,bf16x8 pa0,bf16x8 pa1,bf16x8 pa2,bf16x8 pa3){
  s16x4 lo[2][4],hi[2][4];
  #define RD8(set,ks) do{ _Pragma("unroll") for(int d0=0;d0<4;++d0){ \
      asm volatile("ds_read_b64_tr_b16 %0,%1 offset:%c2":"=&v"(lo[set][d0]):"v"(vb),"i"(d0*4096+(ks)*1024):"memory"); \
      asm volatile("ds_read_b64_tr_b16 %0,%1 offset:%c2":"=&v"(hi[set][d0]):"v"(vb),"i"(d0*4096+(ks)*1024+512):"memory");} }while(0)
  #define PK(set,k) (bf16x8){lo[set][k][0],lo[set][k][1],lo[set][k][2],lo[set][k][3],hi[set][k][0],hi[set][k][1],hi[set][k][2],hi[set][k][3]}
  #define MM4(set,pa) do{ o[0]=__builtin_amdgcn_mfma_f32_32x32x16_bf16(pa,PK(set,0),o[0],0,0,0); o[1]=__builtin_amdgcn_mfma_f32_32x32x16_bf16(pa,PK(set,1),o[1],0,0,0); \
      o[2]=__builtin_amdgcn_mfma_f32_32x32x16_bf16(pa,PK(set,2),o[2],0,0,0); o[3]=__builtin_amdgcn_mfma_f32_32x32x16_bf16(pa,PK(set,3),o[3],0,0,0); }while(0)
  RD8(0,0);
  RD8(1,1); asm volatile("s_waitcnt lgkmcnt(8)":::"memory"); SBAR(); MM4(0,pa0); SBAR();
  RD8(0,2); asm volatile("s_waitcnt lgkmcnt(8)":::"memory"); SBAR(); MM4(1,pa1); SBAR();
  RD8(1,3); asm volatile("s_waitcnt lgkmcnt(8)":::"memory"); SBAR(); MM4(0,pa2); SBAR();
  asm volatile("s_waitcnt lgkmcnt(0)":::"memory"); SBAR(); MM4(1,pa3);
  #undef RD8
  #undef PK
  #undef MM4
}
#ifndef ATTN_STORE16
#define ATTN_STORE16(p,v) (*(u32x4*)(p)=(v))
#endif
template<int THRL> __device__ __forceinline__ void attn_unit(int b,int h,int qb,const bf16*Q,const bf16*__restrict__ K,const bf16*__restrict__ V,bf16*O,char*shm,lds_cfptr bt,const int wid_in){
  const int wid=wid_in,lane=fresh_lane(),r32=lane&31,hi=lane>>5;
  const long rowbase=(long)b*SEQ; const int q0=qb*QB;
  const bf16*Kh=K+rowbase*DM+h*D,*Vh=V+rowbase*DM+(h>>1)*128;
  const unsigned lds0=(unsigned)(uintptr_t)shm;
  const bf16*ksrc=Kh+(long)lane*DM+wid*8;
  const bf16*vsrc=Vh+(long)(16*(wid&3)+(lane>>2))*DM+(wid>>2)*32+(lane&3)*8;
  const unsigned kdst=lds0+LDS_K+wid*1024, vdst=lds0+LDS_V+wid*1024;
  #define DMA_K(t,slot) glds16(ksrc+(long)(t)*KVBLK*DM,(unsigned)__builtin_amdgcn_readfirstlane(kdst+(slot)))
  #define VOFF(t) ((int)(((t)&(NVSLOT-1))*VSLOTB))
  #define DMA_V(t) do{ glds16(vsrc+(long)(t)*KVBLK*DM,(unsigned)__builtin_amdgcn_readfirstlane(vdst+VOFF(t))); glds16(vsrc+64+(long)(t)*KVBLK*DM,(unsigned)__builtin_amdgcn_readfirstlane(vdst+VOFF(t)+8192)); }while(0)
  typedef __attribute__((address_space(3))) char* lds_ptr; typedef __attribute__((address_space(3))) float* lds_fptr;
  const lds_ptr shm3=(lds_ptr)shm;
  const lds_fptr wsf=(lds_fptr)(shm3+LDS_WS+wid*256);
  const int NT=(q0+QB)/KVBLK;
  int sl_prev=0,sl_cur=0,sl_next=SLOTB;
  #define ROT() do{sl_prev=sl_cur;sl_cur=sl_next;sl_next=(sl_next==(NSLOT-1)*SLOTB)?0:sl_next+SLOTB;}while(0)
  #define ENDW(tt) do{ if((tt)+3<NT){WAIT_BAR(3);} else if((tt)+2<NT){WAIT_BAR(2);} else {WAIT_BAR(0);} }while(0)
  DMA_K(0,0);DMA_V(0);DMA_K(1,SLOTB);DMA_V(1);DMA_K(2,2*SLOTB);DMA_V(2);
  const bf16*Qw=Q+(rowbase+q0+wid*QBLK)*DM+h*D;
  bf16x8 qr[4];
  #pragma unroll
  for(int d0=0;d0<4;++d0)qr[d0]=*reinterpret_cast<const bf16x8*>(&Qw[(long)r32*DM+d0*16+hi*8]);
  float mhat=0.f,l_reg=0.f;f32x16 negm;f32x16 o[4];
  _Pragma("unroll") for(int r=0;r<16;++r){float z0,z1,z2,z3,z4; asm volatile("v_mov_b32 %0, 0\n\tv_mov_b32 %1, 0\n\tv_mov_b32 %2, 0\n\tv_mov_b32 %3, 0\n\tv_mov_b32 %4, 0":"=v"(z0),"=v"(z1),"=v"(z2),"=v"(z3),"=v"(z4)); o[0][r]=z0;o[1][r]=z1;o[2][r]=z2;o[3][r]=z3;negm[r]=z4;}
  const int qrel=wid*QBLK+r32;
  const lds_cptr kp0=(lds_cptr)shm3+LDS_K+hi*1024+r32*16;
  const int vb0=(int)(lds0+LDS_V)+((lane>>4)&1)*32+(lane&3)*8+(4*hi+((lane&15)>>2))*64;
  bf16x8 kf[8];
  #define MF(a,b,c) __builtin_amdgcn_mfma_f32_32x32x16_bf16(a,b,c,0,0,0)
  #define MX3(a,b,c) __builtin_fmaxf(__builtin_fmaxf((a),(b)),(c))
  u32x4 pw0,pw1,pw2,pw3;
  #define RD8(set,ks) do{ _Pragma("unroll") for(int d0=0;d0<4;++d0){ \
      asm volatile("ds_read_b64_tr_b16 %0,%1 offset:%c2":"=&v"(vlo_[set][d0]):"v"(vb_),"i"(d0*4096+(ks)*1024):"memory"); \
      asm volatile("ds_read_b64_tr_b16 %0,%1 offset:%c2":"=&v"(vhi_[set][d0]):"v"(vb_),"i"(d0*4096+(ks)*1024+512):"memory");} }while(0)
  #define PK(set,k) (bf16x8){vlo_[set][k][0],vlo_[set][k][1],vlo_[set][k][2],vlo_[set][k][3],vhi_[set][k][0],vhi_[set][k][1],vhi_[set][k][2],vhi_[set][k][3]}
  #define EX2(X,i) do{ X[i]=__builtin_amdgcn_exp2f(X[i]); X[(i)+1]=__builtin_amdgcn_exp2f(X[(i)+1]); sa_+=X[i]; sb_+=X[(i)+1]; asm volatile("":"+v"(sa_),"+v"(sb_)); }while(0)
  #define PVX(set,pw_,X,B) do{ const bf16x8 pa_=__builtin_bit_cast(bf16x8,pw_); \
      o[0]=MF(pa_,PK(set,0),o[0]); EX2(X,(B)+0); asm volatile("":"+v"(X)); SBAR(); \
      o[1]=MF(pa_,PK(set,1),o[1]); EX2(X,(B)+2); asm volatile("":"+v"(X)); SBAR(); \
      o[2]=MF(pa_,PK(set,2),o[2]); EX2(X,(B)+4); asm volatile("":"+v"(X)); SBAR(); \
      o[3]=MF(pa_,PK(set,3),o[3]); EX2(X,(B)+6); asm volatile("":"+v"(X)); SBAR(); }while(0)
  #define ASTEP(s,FIRST,GK,GV,GL,LATE) do{ \
    f32x16 c0=MF(kf[0],qr[0],negm),c1=MF(kf[1],qr[0],negm); c0=MF(kf[2],qr[1],c0);c1=MF(kf[3],qr[1],c1); c0=MF(kf[4],qr[2],c0);c1=MF(kf[5],qr[2],c1); c0=MF(kf[6],qr[3],c0);c1=MF(kf[7],qr[3],c1); \
    if(GK){DMA_K((s)+3,sl_cur);} if(GV){DMA_V((s)+2);} \
    if(GL){kload8(kf,kp0+sl_next);} \
    { const int jb_=(s)-(NT-4); if(jb_>=-2)cmask(c0,c1,jb_,qrel,hi,bt); } \
    float a_=MX3(c0[0],c0[1],c1[0]),b_=MX3(c0[2],c0[3],c1[1]); a_=MX3(a_,c1[2],c1[3]); \
    _Pragma("unroll") for(int r=4;r<16;r+=4){a_=MX3(a_,c0[r],c0[r+1]);b_=MX3(b_,c0[r+2],c0[r+3]);a_=MX3(a_,c1[r],c1[r+1]);b_=MX3(b_,c1[r+2],c1[r+3]);} \
    float rm=__builtin_fmaxf(a_,b_); { auto rr=__builtin_amdgcn_permlane32_swap(__float_as_uint(rm),__float_as_uint(rm),false,false); rm=__builtin_fmaxf(__uint_as_float(rr[0]),__uint_as_float(rr[1])); } \
    bool resc_=false; \
    if(FIRST){ const float dl=rm; mhat+=dl; _Pragma("unroll") for(int r=0;r<16;++r){c0[r]-=dl;c1[r]-=dl;} _Pragma("unroll") for(int r=0;r<16;++r)negm[r]=-mhat; asm volatile("":"+v"(negm)); } \
    else if(__builtin_expect(__any(rm>(float)THRL),0)){ const float dl=__builtin_fmaxf(rm,0.f); mhat+=dl; \
      _Pragma("unroll") for(int r=0;r<16;++r){c0[r]-=dl;c1[r]-=dl;} _Pragma("unroll") for(int r=0;r<16;++r)negm[r]=-mhat; asm volatile("":"+v"(negm)); \
      const float f=__builtin_amdgcn_exp2f(-dl); l_reg*=f; if(hi==0)wsf[r32]=f; resc_=true; } \
    float sa_=0.f,sb_=0.f; \
    if(FIRST){ _Pragma("unroll") for(int r=0;r<16;++r){c0[r]=__builtin_amdgcn_exp2f(c0[r]);c1[r]=__builtin_amdgcn_exp2f(c1[r]);sa_+=c0[r];sb_+=c1[r];} } \
    else { s16x4 vlo_[2][4],vhi_[2][4]; const int vb_=vb0+VOFF((s)-1); \
      SBAR(); \
      RD8(0,0); \
      RD8(1,1); asm volatile("s_waitcnt lgkmcnt(8)":::"memory"); SBAR(); PVX(0,pw0,c0,0); \
      RD8(0,2); asm volatile("s_waitcnt lgkmcnt(8)":::"memory"); SBAR(); PVX(1,pw1,c0,8); \
      RD8(1,3); asm volatile("s_waitcnt lgkmcnt(8)":::"memory"); SBAR(); PVX(0,pw2,c1,0); \
      asm volatile("s_waitcnt lgkmcnt(0)":::"memory"); SBAR(); PVX(1,pw3,c1,8); \
      if(resc_){ _Pragma("unroll") for(int r=0;r<16;++r){ const float f_=wsf[crow(r,hi)]; o[0][r]*=f_;o[1][r]*=f_;o[2][r]*=f_;o[3][r]*=f_; } } } \
    l_reg+=sa_+sb_; \
    pw0=(u32x4){cvtpk_s(c0[0],c0[1]),cvtpk_s(c0[2],c0[3]),cvtpk_s(c0[4],c0[5]),cvtpk_s(c0[6],c0[7])}; pw1=(u32x4){cvtpk_s(c0[8],c0[9]),cvtpk_s(c0[10],c0[11]),cvtpk_s(c0[12],c0[13]),cvtpk_s(c0[14],c0[15])}; \
    pw2=(u32x4){cvtpk_s(c1[0],c1[1]),cvtpk_s(c1[2],c1[3]),cvtpk_s(c1[4],c1[5]),cvtpk_s(c1[6],c1[7])}; pw3=(u32x4){cvtpk_s(c1[8],c1[9]),cvtpk_s(c1[10],c1[11]),cvtpk_s(c1[12],c1[13]),cvtpk_s(c1[14],c1[15])}; \
  }while(0)
  WAIT_BAR(3);
  kload8(kf,kp0);
  #define STEPS(LATE) do{ \
    ASTEP(0,true,false,false,true,LATE);                      \
    WAIT_BAR(0);                                              \
    DMA_K(3,0);                                               \
    ROT(); \
    int t=1; \
    for(;t+7<NT;t+=2){ \
      ASTEP(t,false,true,true,true,LATE);     WAIT_BAR(3); ROT(); \
      ASTEP(t+1,false,true,true,true,LATE);   WAIT_BAR(3); ROT(); \
    } \
    for(;t+1<NT;t+=2){ \
      ASTEP(t,false,(t+3<NT),(t+2<NT),(t+1<NT),LATE);       ENDW(t);   ROT(); \
      ASTEP(t+1,false,(t+4<NT),(t+3<NT),(t+2<NT),LATE);     ENDW(t+1); ROT(); \
    } \
    ASTEP(NT-1,false,false,false,false,LATE); \
    if(LATE){ pv4(o,vb0+VOFF(NT-1),__builtin_bit_cast(bf16x8,pw0),__builtin_bit_cast(bf16x8,pw1),__builtin_bit_cast(bf16x8,pw2),__builtin_bit_cast(bf16x8,pw3)); } \
  }while(0)
  if(wid>=4) __builtin_amdgcn_s_setprio(1);
  STEPS(true);
  __builtin_amdgcn_s_setprio(0);
  #undef STEPS
  #undef ASTEP
  #undef PVX
  #undef EX2
  #undef PK
  #undef RD8
  #undef MF
  #undef MX3
  {auto rr=__builtin_amdgcn_permlane32_swap(__float_as_uint(l_reg),__float_as_uint(l_reg),false,false);l_reg=__uint_as_float(rr[0])+__uint_as_float(rr[1]);}
  if(hi==0)wsf[32+r32]=l_reg;
  asm volatile("s_waitcnt vmcnt(0) lgkmcnt(0)\n\ts_barrier":::"memory");
  float rli[16];
  #pragma unroll
  for(int r=0;r<16;++r)rli[r]=__builtin_amdgcn_rcpf(wsf[32+crow(r,hi)]);
  bf16*Ow=O+(rowbase+q0+wid*QBLK)*ODM+h*128;
  { bf16*stg=(bf16*)(shm+wid*8192);
    #pragma unroll
    for(int r=0;r<16;++r){const int orow=crow(r,hi);
      #pragma unroll
      for(int d0=0;d0<4;++d0)stg[orow*128+d0*32+r32]=__float2bfloat16(o[d0][r]*rli[r]);}
    asm volatile("s_waitcnt lgkmcnt(0)":::"memory");
    #pragma unroll
    for(int i=0;i<8;++i){const int row=i*4+(lane>>4),ch=lane&15; const u32x4 v=*(const u32x4*)(stg+row*128+ch*8); ATTN_STORE16(Ow+(long)row*ODM+ch*8,v);} }
  asm volatile("s_waitcnt lgkmcnt(0)\n\ts_barrier":::"memory");
  #undef DMA_K
  #undef DMA_V
  #undef VOFF
  #undef ROT
  #undef ENDW
}
constexpr int ATTN_LDS_BYTES=LDS_BYTES;
#undef SBAR
#undef WAIT_BAR
}
#define LAS __attribute__((address_space(3)))
typedef unsigned short bf16;
typedef unsigned v4u __attribute__((ext_vector_type(4)));
typedef unsigned v2u __attribute__((ext_vector_type(2)));
typedef float f32x4 __attribute__((ext_vector_type(4)));
typedef short bf16x8 __attribute__((ext_vector_type(8)));
typedef float f32x16 __attribute__((ext_vector_type(16)));
#define LDS_WAIT() asm volatile("s_waitcnt lgkmcnt(0)" ::: "memory")
constexpr int NWAVES = 8, NTHR = 512;
constexpr int D = 2048, MROWS = 33792, MP = 32768, NIN = 5120, DFF = 5632;
constexpr float EPS = 1e-6f, LOG2E = 1.4426950408889634f;
constexpr size_t MiB = 1u << 20;
constexpr size_t WS_BAR = 983040, WS_MOD = 0, WS_MODF = 1 * MiB, WS_WIN = 2 * MiB, WS_WOUT = 22 * MiB, WS_WFI = 30 * MiB, WS_WFO = 74 * MiB, WS_H = 96 * MiB, WS_CAT = 228 * MiB,
                 WS_U = 360 * MiB, WS_G = 426 * MiB, WS_Q = 492 * MiB, WS_K = 558 * MiB, WS_V = 624 * MiB, WS_O = 690 * MiB, WS_F = 228 * MiB, WS_X1B = 690 * MiB, WS_X2B = 96 * MiB, WS_PART = 822 * MiB, WS_END = 854 * MiB;
constexpr long OUT_Y = 0, OUT_GVS = 138412032L;
constexpr int LDS_BYTES = 147456, RING_BYTES = 131072, BT_OFF = 126976;
static_assert(attn_body::ATTN_LDS_BYTES <= BT_OFF && BT_OFF + 8 * 196 * 4 <= LDS_BYTES, "LDS map");

__device__ __forceinline__ unsigned f2bf(float f) { unsigned u = __builtin_bit_cast(unsigned, f); return (u + 0x7fffu + ((u >> 16) & 1u)) >> 16; }
typedef float f32x2_pk __attribute__((ext_vector_type(2))); typedef __bf16 bf16x2_pk __attribute__((ext_vector_type(2)));
__device__ __forceinline__ unsigned pk2(float lo, float hi) { f32x2_pk v = {lo, hi}; bf16x2_pk b = __builtin_convertvector(v, bf16x2_pk); return __builtin_bit_cast(unsigned, b); }
__device__ __forceinline__ float bf2f(unsigned short h) { return __builtin_bit_cast(float, (unsigned)h << 16); }
__device__ __forceinline__ float bflo(unsigned w) { return __builtin_bit_cast(float, w << 16); }
__device__ __forceinline__ float bfhi(unsigned w) { return __builtin_bit_cast(float, w & 0xffff0000u); }
__device__ __forceinline__ float wave_sum(float v) {
#pragma unroll
    for (int o = 1; o < 64; o <<= 1) v += __shfl_xor(v, o);
    return v;
}
__device__ __forceinline__ int row_batch(int row) { return row < MP ? (row >> 14) : 2 + ((row - MP) >> 6); }

struct Args { const float* in[27]; float* out; unsigned char* ws; int ph_lo, ph_hi; };
enum { I_XP = 0, I_XS, I_CK, I_CV, I_CP, I_CS, I_RB, I_WADA, I_BADA, I_WADAF, I_BADAF, I_GMIX, I_GFFN, I_GFIN, I_WIN, I_LNG, I_LNB, I_WS, I_BS, I_LQ1, I_LK1, I_LQ2, I_LK2, I_SUBG, I_WOUT, I_WFI, I_WFO };

__device__ __forceinline__ void p0_transpose_item(const float* W, int K, int N, bf16* WT, int mode, LAS float* scr, int item, int lane) {
    const int nblk = N / 64, kb = item / nblk, nb = item % nblk, k0 = 64 * kb, n0 = 64 * nb;
    int rbase = n0;
    if (mode == 1) { const int j = n0 < DFF ? n0 : n0 - DFF; rbase = (j >> 7) * 256 + (n0 < DFF ? 0 : 128) + (j & 127); }
    const float* src = W + (size_t)k0 * N + n0 + lane;
    float wv[64];
#pragma unroll
    for (int i = 0; i < 64; ++i) wv[i] = src[(size_t)i * N];
#pragma unroll
    for (int i = 0; i < 64; ++i) scr[i * 65 + lane] = wv[i];
    LDS_WAIT(); asm volatile("" ::: "memory");
    const int c = lane & 7;
#pragma unroll
    for (int j = 0; j < 8; ++j) { const int n = (lane >> 3) + 8 * j; const LAS float* s = scr + (8 * c) * 65 + n;
        v4u o; o.x = pk2(s[0 * 65], s[1 * 65]); o.y = pk2(s[2 * 65], s[3 * 65]); o.z = pk2(s[4 * 65], s[5 * 65]); o.w = pk2(s[6 * 65], s[7 * 65]);
        *(v4u*)(WT + (size_t)(rbase + n) * K + k0 + 8 * c) = o; }
    LDS_WAIT(); asm volatile("" ::: "memory");
}
__device__ __forceinline__ void adaln_unit(const Args& a, LAS unsigned char* lds, int unit, int tid, int wave, int lane) {
    LAS float* sc = (LAS float*)lds;
    LAS float* red = (LAS float*)(lds + 18 * 1024 * 4);
    const int j0 = unit * 64; const bool fin = j0 >= 12288;
    const float* W = fin ? a.in[I_WADAF] : a.in[I_WADA]; const int N = fin ? 4096 : 12288; const int jc = (fin ? j0 - 12288 : j0) + lane;
    float acc[18];
#pragma unroll
    for (int r = 0; r < 18; ++r) acc[r] = 0.f;
    for (int kh = 0; kh < 2; ++kh) {
        __syncthreads();
        for (int i = tid; i < 18 * 1024; i += NTHR) { const int r = i >> 10, k = (i & 1023) + kh * 1024; const float c = r < 2 ? a.in[I_CP][r * 2048 + k] : a.in[I_CS][(r - 2) * 2048 + k];
            sc[i] = c / (1.0f + __expf(-c)); }
        __syncthreads();
        const int kb = wave * 128;
        for (int k = 0; k < 128; k += 16) {
            float w[16];
#pragma unroll
            for (int e = 0; e < 16; ++e) w[e] = W[(size_t)(kh * 1024 + kb + k + e) * N + jc];
#pragma unroll
            for (int q = 0; q < 4; ++q)
#pragma unroll
                for (int r = 0; r < 18; ++r) { const f32x4 s = *(const LAS f32x4*)(sc + r * 1024 + kb + k + 4 * q); acc[r] += s[0] * w[4 * q] + s[1] * w[4 * q + 1] + s[2] * w[4 * q + 2] + s[3] * w[4 * q + 3]; }
        }
    }
#pragma unroll
    for (int r = 0; r < 18; ++r) red[(wave * 18 + r) * 64 + lane] = acc[r];
    __syncthreads();
    for (int i = tid; i < 18 * 64; i += NTHR) { const int r = i >> 6, l = i & 63; float s = 0.f;
#pragma unroll
        for (int w = 0; w < 8; ++w) s += red[(w * 18 + r) * 64 + l];
        const int j = (fin ? j0 - 12288 : j0) + l;
        if (fin) ((float*)(a.ws + WS_MODF))[r * 4096 + j] = s + a.in[I_BADAF][j]; else ((float*)(a.ws + WS_MOD))[r * 12288 + j] = s + a.in[I_BADA][j]; }
    __syncthreads();
}
__device__ __forceinline__ void p0_prologue(const Args& a, LAS unsigned char* lds, int vcu, int G, int tid, int wave, int lane) {
    for (int rp = 0, nrp = opaque_i(((PROBE_REP >> 12) & 1) ? 2 : 1); rp < nrp; ++rp)
    for (int u = vcu; u < 256; u += G) adaln_unit(a, lds, u, tid, wave, lane);
    LAS float* scr = (LAS float*)(lds + wave * 17408);
    const int gw = vcu * NWAVES + wave, NGW = G * NWAVES;
    constexpr int I_1 = (D / 64) * (NIN / 64), I_2 = (D / 64) * (D / 64), I_3 = (D / 64) * (2 * DFF / 64), I_4 = (DFF / 64) * (D / 64);
    for (int it = gw; it < I_1 + I_2 + I_3 + I_4; it += NGW) {
        int r = it;
        if (r < I_1) { p0_transpose_item(a.in[I_WIN], D, NIN, (bf16*)(a.ws + WS_WIN), 0, scr, r, lane); continue; } r -= I_1;
        if (r < I_2) { p0_transpose_item(a.in[I_WOUT], D, D, (bf16*)(a.ws + WS_WOUT), 0, scr, r, lane); continue; } r -= I_2;
        if (r < I_3) { p0_transpose_item(a.in[I_WFI], D, 2 * DFF, (bf16*)(a.ws + WS_WFI), 1, scr, r, lane); continue; } r -= I_3;
        p0_transpose_item(a.in[I_WFO], DFF, D, (bf16*)(a.ws + WS_WFO), 0, scr, r, lane);
    }
}
template <bool F32OUT> __device__ __forceinline__ void norm_mod_rows(const float* fp, const float* fs, const bf16* bp, const bf16* bs, const float* g, const float* shift, const float* scale, int mstride, void* dst, int gw, int NGW, int lane, const float* part = nullptr, bf16* wb = nullptr) {
    for (int row = gw; row < MROWS; row += NGW) {
        const bool smp = row >= MP;
        const float* srcf = smp ? (fs ? fs + (size_t)(row - MP) * D : nullptr) : (fp ? fp + (size_t)row * D : nullptr);
        const bf16* srcb = (smp ? bs : bp) + (size_t)row * D;
        const int b = row_batch(row);
        f32x4 v[8]; float s = 0.f;
        if (srcf) {
#pragma unroll
            for (int j = 0; j < 8; ++j) v[j] = *(const f32x4*)(srcf + 4 * lane + 256 * j);
        } else {
#pragma unroll
            for (int j = 0; j < 8; ++j) { const v2u w = *(const v2u*)(srcb + 4 * lane + 256 * j); v[j] = (f32x4){bflo(w.x), bfhi(w.x), bflo(w.y), bfhi(w.y)}; }
        }
        if (part && smp) {
#pragma unroll
            for (int sp = 0; sp < 4; ++sp) { const float* pp = part + ((size_t)sp * (MROWS - MP) + (size_t)(row - MP)) * D + 4 * lane;
#pragma unroll
                for (int j = 0; j < 8; ++j) v[j] += *(const f32x4*)(pp + 256 * j); }
            if (wb) {
#pragma unroll
                for (int j = 0; j < 8; ++j) { v2u w; w.x = pk2(v[j][0], v[j][1]); w.y = pk2(v[j][2], v[j][3]); *(v2u*)(wb + (size_t)row * D + 4 * lane + 256 * j) = w; } }
        }
#pragma unroll
        for (int j = 0; j < 8; ++j) s += (v[j][0] * v[j][0] + v[j][1] * v[j][1]) + (v[j][2] * v[j][2] + v[j][3] * v[j][3]);
        const float rstd = 1.0f / sqrtf(wave_sum(s) * (1.0f / D) + EPS);
#pragma unroll
        for (int j = 0; j < 8; ++j) { const int col = 4 * lane + 256 * j;
            const f32x4 gg = *(const f32x4*)(g + col), sh = *(const f32x4*)(shift + (size_t)b * mstride + col), sc = *(const f32x4*)(scale + (size_t)b * mstride + col);
            const f32x4 o = (v[j] * rstd * gg) * (sc + 1.0f) + sh;
            if (F32OUT) *(f32x4*)((float*)dst + (size_t)row * D + col) = o;
            else { v2u w; w.x = pk2(o[0], o[1]); w.y = pk2(o[2], o[3]); *(v2u*)((bf16*)dst + (size_t)row * D + col) = w; } }
    }
}
__device__ __forceinline__ float diff_lambda(const Args& a, int lane) {
    const float s1 = wave_sum(a.in[I_LQ1][lane] * a.in[I_LK1][lane]), s2 = wave_sum(a.in[I_LQ2][lane] * a.in[I_LK2][lane]);
    return __expf(s1) - __expf(s2) + 0.2f;
}
__device__ __forceinline__ void bias_table(const Args& a, LAS float* bt, int tid) {
    for (int i = tid; i < 8 * 193; i += NTHR) { const int h = i / 193, idx = i % 193, rel = idx - 128, n = rel < 0 ? -rel : rel;
        int bk; if (n < 8) bk = n; else { const int q = (n * n) >> 6; bk = 8 + (31 - __clz(q)); if (bk > 15) bk = 15; }
        if (rel > 0) bk += 16;
        bt[h * 196 + idx] = (a.in[I_RB][bk * 8 + h] - a.in[I_RB][15 * 8 + h]) * LOG2E; }
}
__device__ __forceinline__ int crow(int r, int hi) { return (r & 3) + 8 * (r >> 2) + 4 * hi; }
__device__ __forceinline__ bf16x8 cvt8(f32x4 a, f32x4 b) { v4u w; w.x = pk2(a[0], a[1]); w.y = pk2(a[2], a[3]); w.z = pk2(b[0], b[1]); w.w = pk2(b[2], b[3]); return __builtin_bit_cast(bf16x8, w); }

constexpr int TSTR = 136;
__device__ __forceinline__ void unpack16(const v4u w0, const v4u w1, float* v) {
    v[0] = bflo(w0.x); v[1] = bfhi(w0.x); v[2] = bflo(w0.y); v[3] = bfhi(w0.y); v[4] = bflo(w0.z); v[5] = bfhi(w0.z); v[6] = bflo(w0.w); v[7] = bfhi(w0.w);
    v[8] = bflo(w1.x); v[9] = bfhi(w1.x); v[10] = bflo(w1.y); v[11] = bfhi(w1.y); v[12] = bflo(w1.z); v[13] = bfhi(w1.z); v[14] = bflo(w1.w); v[15] = bfhi(w1.w);
}
__device__ __forceinline__ void sgate_unit(const Args& a, LAS unsigned char* lds, int c, int tid, int wave, int lane) {
    asm volatile("" : "+v"(lane), "+v"(tid));
    const bool smp = c >= 256; const int T = smp ? 64 : 128; const int row0 = smp ? MP + 64 * (c - 256) : 128 * c;
    const bf16* Gb = (const bf16*)(a.ws + WS_G); const bf16* Ub = (const bf16*)(a.ws + WS_U); bf16* CAT = (bf16*)(a.ws + WS_CAT);
    LAS bf16* tile0 = (LAS bf16*)lds;
    LAS float* stats = (LAS float*)(lds + 65536);
    __syncthreads();
    for (int rb = 0; rb < 16; rb += 4) { const int rbase = wave * 16 + rb; if (rbase >= T) break;
        v4u w[4][2];
#pragma unroll
        for (int q = 0; q < 4; ++q) { const v4u* gp = (const v4u*)(Gb + (size_t)(row0 + rbase + q) * 1024 + lane * 16); w[q][0] = gp[0]; w[q][1] = gp[1]; }
        float s1[4], s2[4];
#pragma unroll
        for (int q = 0; q < 4; ++q) { float v[16]; unpack16(w[q][0], w[q][1], v); s1[q] = 0.f; s2[q] = 0.f;
#pragma unroll
            for (int e = 0; e < 16; ++e) { s1[q] += v[e]; s2[q] += v[e] * v[e]; } }
#pragma unroll
        for (int o = 1; o < 64; o <<= 1) {
#pragma unroll
            for (int q = 0; q < 4; ++q) { s1[q] += __shfl_xor(s1[q], o); s2[q] += __shfl_xor(s2[q], o); } }
#pragma unroll
        for (int q = 0; q < 4; ++q) { const float mean = s1[q] * (1.0f / 1024.0f); const float var = fmaxf(s2[q] * (1.0f / 1024.0f) - mean * mean, 0.f); const float rstd = 1.0f / sqrtf(var + EPS);
            if (lane == 0) { stats[(rbase + q) * 2] = mean; stats[(rbase + q) * 2 + 1] = rstd; } } }
    __syncthreads();
    const int hi = lane >> 5, r32 = lane & 31, iblk = wave & 3, cpair = wave >> 2;
    const bool act = iblk * 32 < T; const int nks = iblk < 2 ? 4 : 8;
    const int nch = T * 16 / NTHR;
    v4u gpre[4];
#define SG_ISSUE(g) do { _Pragma("unroll") for (int q = 0; q < 4; ++q) if (q < nch) { const int idx = tid + q * NTHR; gpre[q] = *(const v4u*)(Gb + (size_t)(row0 + (idx >> 4)) * 1024 + (g) * 128 + (idx & 15) * 8); } } while (0)
#define SG_COMMIT(g) do { LAS bf16* tl = tile0 + ((g) & 1) * 16384; _Pragma("unroll") for (int q = 0; q < 4; ++q) if (q < nch) { const int idx = tid + q * NTHR; const int row = idx >> 4, c8 = (idx & 15) * 8; const v4u w = gpre[q]; \
            const float mean = stats[row * 2], rstd = stats[row * 2 + 1]; \
            const float* lg = a.in[I_LNG] + (g) * 128 + c8; const float* lb = a.in[I_LNB] + (g) * 128 + c8; \
            const f32x4 g0 = *(const f32x4*)lg, g1 = *(const f32x4*)(lg + 4), b0 = *(const f32x4*)lb, b1 = *(const f32x4*)(lb + 4); \
            f32x4 x0 = {bflo(w.x), bfhi(w.x), bflo(w.y), bfhi(w.y)}, x1 = {bflo(w.z), bfhi(w.z), bflo(w.w), bfhi(w.w)}; \
            x0 = (x0 - mean) * rstd * g0 + b0; x1 = (x1 - mean) * rstd * g1 + b1; \
            if (smp) { float* o = a.out + OUT_GVS + (size_t)(row0 - MP + row) * 1024 + (g) * 128 + c8; *(f32x4*)o = x0; *(f32x4*)(o + 4) = x1; } \
            v4u o; o.x = pk2(x0[0], x0[1]); o.y = pk2(x0[2], x0[3]); o.z = pk2(x1[0], x1[1]); o.w = pk2(x1[2], x1[3]); \
            *(LAS v4u*)(tl + (c8 >> 5) * 4096 + row * 32 + (c8 & 31)) = o; } } while (0)
    SG_ISSUE(0); SG_COMMIT(0);
    __syncthreads();
    for (int g = 0; g < 8; ++g) {
        if (g < 7) SG_ISSUE(g + 1);
        if (act) {
            const LAS bf16* tile = tile0 + (g & 1) * 16384;
            const float* wrow = a.in[I_WS] + ((size_t)g * 128 + iblk * 32 + r32) * 128 + 4 * hi;
            f32x4 ar[8][2];
#pragma unroll
            for (int ks = 0; ks < 8; ++ks) if (ks < nks) { ar[ks][0] = *(const f32x4*)(wrow + ks * 16); ar[ks][1] = *(const f32x4*)(wrow + ks * 16 + 8); }
            unsigned uu[16];
#pragma unroll
            for (int r = 0; r < 16; ++r) { const int i = iblk * 32 + crow(r, hi); const size_t ro = (size_t)(row0 + i); const int col = g * 128 + cpair * 64 + r32;
                uu[r] = (unsigned)Ub[ro * 1024 + col] | ((unsigned)Ub[ro * 1024 + col + 32] << 16); }
            f32x16 acc0 = {}, acc1 = {};
#pragma unroll
            for (int ks = 0; ks < 8; ++ks) if (ks < nks) {
                const bf16x8 af = cvt8(ar[ks][0], ar[ks][1]);
                const attn_body::lds_cptr tp = (attn_body::lds_cptr)tile + (cpair * 2) * 8192 + ks * 1024 + ((lane >> 4) & 1) * 32 + (lane & 3) * 8 + (4 * hi + ((lane & 15) >> 2)) * 64;
                const attn_body::s16x4 l0 = attn_body::vtr(tp), h0 = attn_body::vtr(tp + 512), l1 = attn_body::vtr(tp + 8192), h1 = attn_body::vtr(tp + 8192 + 512);
                const bf16x8 b0 = {l0[0], l0[1], l0[2], l0[3], h0[0], h0[1], h0[2], h0[3]}, b1 = {l1[0], l1[1], l1[2], l1[3], h1[0], h1[1], h1[2], h1[3]};
                acc0 = __builtin_amdgcn_mfma_f32_32x32x16_bf16(af, b0, acc0, 0, 0, 0);
                acc1 = __builtin_amdgcn_mfma_f32_32x32x16_bf16(af, b1, acc1, 0, 0, 0);
            }
#pragma unroll
            for (int r = 0; r < 16; ++r) { const int i = iblk * 32 + crow(r, hi);
                const size_t ro = (size_t)(row0 + i); const int col = g * 128 + cpair * 64 + r32;
                const float bs = a.in[I_BS][g * 128 + i];
                CAT[ro * 2048 + col] = (bf16)f2bf(bflo(uu[r]) * (acc0[r] + bs)); CAT[ro * 2048 + col + 32] = (bf16)f2bf(bfhi(uu[r]) * (acc1[r] + bs)); }
        }
        if (g < 7) SG_COMMIT(g + 1);
        __syncthreads();
    }
#undef SG_ISSUE
#undef SG_COMMIT
}
__device__ __forceinline__ void sattn_unit(const Args& a, LAS unsigned char* lds, const LAS float* bt, int db, int h, int t, int tid, int wave, int lane) {
    asm volatile("" : "+v"(lane), "+v"(tid));
    const int qg = wave & 1, dvh = (wave >> 1) & 1, ksp = wave >> 2, hi = lane >> 5, r32 = lane & 31;
    const bf16* Qb = (const bf16*)(a.ws + WS_Q); const bf16* Kb = (const bf16*)(a.ws + WS_K); const bf16* Vb = (const bf16*)(a.ws + WS_V); bf16* Ob = (bf16*)(a.ws + WS_O);
    const float* CK = a.in[I_CK]; const float* CV = a.in[I_CV];
    const LAS float* bth = bt + h * 196;
    bf16x8 qr[4];
    { const bf16* qp = Qb + (size_t)(MP + db * 64 + qg * 32 + r32) * 1024 + h * 128 + t * 64 + hi * 8;
#pragma unroll
      for (int d0 = 0; d0 < 4; ++d0) qr[d0] = *(const bf16x8*)(qp + d0 * 16); }
    float m = -1e30f, l = 0.f; f32x16 o[2];
    o[0] = f32x16{}; o[1] = f32x16{};
    const unsigned klo = (unsigned)(r32 * 1024 + hi * 8), vlo = (unsigned)(hi * 4096 + dvh * 64 + r32), kco = (unsigned)((lane >> 4) * 1024 + (lane & 15) * 4);
    LAS float* kst = (LAS float*)(lds + 40960 + wave * 8704);
    f32x4 kr[8]; float vr[2][16];
#define SA_LOAD(K0) do { const float* kpu = CK + ((size_t)(db * 2048 + (K0)) * 8 + h) * 128 + t * 64; const float* vpu = CV + ((size_t)(db * 2048 + (K0)) * 8 + h) * 128; \
        _Pragma("unroll") for (int j = 0; j < 8; ++j) kr[j] = *(const f32x4*)(kpu + (kco + j * 4096)); \
        _Pragma("unroll") for (int e = 0; e < 8; ++e) { const float* r0 = vpu + crow(e, 0) * 1024; const float* r1 = vpu + (16 + crow(e, 0)) * 1024; \
            _Pragma("unroll") for (int d2 = 0; d2 < 2; ++d2) { vr[d2][e] = r0[vlo + d2 * 32]; vr[d2][8 + e] = r1[vlo + d2 * 32]; } } } while (0)
#define SA_CVT() do { _Pragma("unroll") for (int j = 0; j < 8; ++j) *(LAS f32x4*)(kst + ((lane >> 4) + 4 * j) * 68 + (lane & 15) * 4) = kr[j]; \
        _Pragma("unroll") for (int d0 = 0; d0 < 4; ++d0) { const LAS float* kp_ = kst + r32 * 68 + d0 * 16 + hi * 8; kf[d0] = cvt8(*(const LAS f32x4*)kp_, *(const LAS f32x4*)(kp_ + 4)); } \
        _Pragma("unroll") for (int d2 = 0; d2 < 2; ++d2) { \
            v4u w0, w1; w0.x = pk2(vr[d2][0], vr[d2][1]); w0.y = pk2(vr[d2][2], vr[d2][3]); w0.z = pk2(vr[d2][4], vr[d2][5]); w0.w = pk2(vr[d2][6], vr[d2][7]); \
            w1.x = pk2(vr[d2][8], vr[d2][9]); w1.y = pk2(vr[d2][10], vr[d2][11]); w1.z = pk2(vr[d2][12], vr[d2][13]); w1.w = pk2(vr[d2][14], vr[d2][15]); \
            vf[d2][0] = __builtin_bit_cast(bf16x8, w0); vf[d2][1] = __builtin_bit_cast(bf16x8, w1); } } while (0)
#define SA_COMPUTE(K0) do { f32x16 s = f32x16{}; \
        _Pragma("unroll") for (int d0 = 0; d0 < 4; ++d0) s = __builtin_amdgcn_mfma_f32_32x32x16_bf16(kf[d0], qr[d0], s, 0, 0, 0); \
        const int relb = (K0) - (2048 + qg * 32 + r32) + 128; float mx = -1e30f; \
        _Pragma("unroll") for (int r = 0; r < 16; ++r) { int idx = relb + crow(r, hi); idx = idx < 0 ? 0 : (idx > 192 ? 192 : idx); s[r] += bth[idx]; mx = fmaxf(mx, s[r]); } \
        mx = fmaxf(mx, __shfl_xor(mx, 32)); \
        const float mn = fmaxf(m, mx); \
        if (__any(mn > m)) { const float alpha = __builtin_amdgcn_exp2f(m - mn); l *= alpha; \
            _Pragma("unroll") for (int r = 0; r < 16; ++r) { const float ar = __shfl(alpha, crow(r, hi)); o[0][r] *= ar; o[1][r] *= ar; } } \
        m = mn; float rs = 0.f; \
        _Pragma("unroll") for (int r = 0; r < 16; ++r) { s[r] = __builtin_amdgcn_exp2f(s[r] - mn); rs += s[r]; } \
        l += rs; \
        v4u p0, p1; p0.x = pk2(s[0], s[1]); p0.y = pk2(s[2], s[3]); p0.z = pk2(s[4], s[5]); p0.w = pk2(s[6], s[7]); \
        p1.x = pk2(s[8], s[9]); p1.y = pk2(s[10], s[11]); p1.z = pk2(s[12], s[13]); p1.w = pk2(s[14], s[15]); \
        const bf16x8 pa0 = __builtin_bit_cast(bf16x8, p0), pa1 = __builtin_bit_cast(bf16x8, p1); \
        _Pragma("unroll") for (int d2 = 0; d2 < 2; ++d2) { \
            o[d2] = __builtin_amdgcn_mfma_f32_32x32x16_bf16(pa0, vf[d2][0], o[d2], 0, 0, 0); \
            o[d2] = __builtin_amdgcn_mfma_f32_32x32x16_bf16(pa1, vf[d2][1], o[d2], 0, 0, 0); } } while (0)
    const int tile0 = ksp * 33, nf = ksp ? 31 : 33;
    SA_LOAD(tile0 * 32);
    for (int it = 0; it < nf; ++it) {
        const int key0 = __builtin_amdgcn_readfirstlane((tile0 + it) * 32);
        bf16x8 kf[4]; bf16x8 vf[2][2];
        SA_CVT();
        if (it + 1 < nf) SA_LOAD(key0 + 32);
        SA_COMPUTE(key0);
    }
    if (ksp == 1) {
        for (int it = 0; it < 2; ++it) {
            const int key0 = 2048 + it * 32;
            bf16x8 kf[4]; bf16x8 vf[2][2];
            const bf16* kpu = Kb + (size_t)(MP + db * 64 + key0 - 2048) * 1024 + h * 128 + t * 64;
            const bf16* vpu = Vb + (size_t)(MP + db * 64 + key0 - 2048) * 1024 + h * 128;
#pragma unroll
            for (int d0 = 0; d0 < 4; ++d0) kf[d0] = *(const bf16x8*)(kpu + (klo + d0 * 16));
#pragma unroll
            for (int e = 0; e < 8; ++e) { const bf16* r0 = vpu + crow(e, 0) * 1024; const bf16* r1 = vpu + (16 + crow(e, 0)) * 1024;
#pragma unroll
                for (int d2 = 0; d2 < 2; ++d2) { vf[d2][0][e] = (short)r0[vlo + d2 * 32]; vf[d2][1][e] = (short)r1[vlo + d2 * 32]; } }
            SA_COMPUTE(key0);
        }
    }
#undef SA_LOAD
#undef SA_CVT
#undef SA_COMPUTE
    l += __shfl_xor(l, 32);
    LAS float* xo = (LAS float*)lds;
    LAS float* xm = (LAS float*)(lds + 4 * 2048 * 4);
    const int slot = wave & 3;
    __syncthreads();
    if (ksp == 1) {
#pragma unroll
        for (int i = 0; i < 2; ++i)
#pragma unroll
            for (int r = 0; r < 16; ++r) xo[(slot * 32 + i * 16 + r) * 64 + lane] = o[i][r];
        xm[(slot * 2 + 0) * 64 + lane] = m; xm[(slot * 2 + 1) * 64 + lane] = l; }
    __syncthreads();
    if (ksp == 0) {
        const float m1 = xm[(slot * 2 + 0) * 64 + lane], l1 = xm[(slot * 2 + 1) * 64 + lane];
        const float mn = fmaxf(m, m1), a0 = __builtin_amdgcn_exp2f(m - mn), a1 = __builtin_amdgcn_exp2f(m1 - mn);
        const float inv = 1.0f / (l * a0 + l1 * a1); const float f0 = a0 * inv, f1 = a1 * inv;
#pragma unroll
        for (int r = 0; r < 16; ++r) { const float g0 = __shfl(f0, crow(r, hi)), g1 = __shfl(f1, crow(r, hi));
            bf16* op = Ob + (size_t)(MP + db * 64 + qg * 32 + crow(r, hi)) * 2048 + h * 256 + t * 128 + dvh * 64 + r32;
#pragma unroll
            for (int i = 0; i < 2; ++i) op[i * 32] = (bf16)f2bf(o[i][r] * g0 + xo[(slot * 32 + i * 16 + r) * 64 + lane] * g1); } }
    __syncthreads();
}
__device__ __forceinline__ void combine_rows(const Args& a, float lam, int gw, int NGW, int lane) {
    const bf16* O = (const bf16*)(a.ws + WS_O); bf16* CAT = (bf16*)(a.ws + WS_CAT);
    const int h = lane >> 3, d0 = (lane & 7) * 16;
    float sg[16];
#pragma unroll
    for (int e = 0; e < 16; ++e) sg[e] = a.in[I_SUBG][d0 + e] * 0.8f;
    for (int row = gw; row < MROWS; row += NGW) {
        const v4u* p1 = (const v4u*)(O + (size_t)row * 2048 + h * 256 + d0); const v4u* p2 = (const v4u*)(O + (size_t)row * 2048 + h * 256 + 128 + d0);
        const v4u a0 = p1[0], a1 = p1[1], b0 = p2[0], b1 = p2[1];
        const unsigned aw[8] = {a0.x, a0.y, a0.z, a0.w, a1.x, a1.y, a1.z, a1.w}, bw[8] = {b0.x, b0.y, b0.z, b0.w, b1.x, b1.y, b1.z, b1.w};
        float d[16]; float q = 0.f;
#pragma unroll
        for (int e = 0; e < 8; ++e) { d[2 * e] = bflo(aw[e]) - lam * bflo(bw[e]); d[2 * e + 1] = bfhi(aw[e]) - lam * bfhi(bw[e]); q += d[2 * e] * d[2 * e] + d[2 * e + 1] * d[2 * e + 1]; }
        q += __shfl_xor(q, 1); q += __shfl_xor(q, 2); q += __shfl_xor(q, 4);
        const float rs = 1.0f / sqrtf(q * (1.0f / 128.0f) + EPS);
        v4u o0, o1;
        o0.x = pk2(d[0] * rs * sg[0], d[1] * rs * sg[1]); o0.y = pk2(d[2] * rs * sg[2], d[3] * rs * sg[3]); o0.z = pk2(d[4] * rs * sg[4], d[5] * rs * sg[5]); o0.w = pk2(d[6] * rs * sg[6], d[7] * rs * sg[7]);
        o1.x = pk2(d[8] * rs * sg[8], d[9] * rs * sg[9]); o1.y = pk2(d[10] * rs * sg[10], d[11] * rs * sg[11]); o1.z = pk2(d[12] * rs * sg[12], d[13] * rs * sg[13]); o1.w = pk2(d[14] * rs * sg[14], d[15] * rs * sg[15]);
        v4u* dst = (v4u*)(CAT + (size_t)row * 2048 + 1024 + h * 128 + d0); dst[0] = o0; dst[1] = o1;
    }
}

constexpr int NPH = 10;
__global__ void __launch_bounds__(NTHR, 2) fwd_megakernel(Args args) {
    extern __shared__ __attribute__((aligned(16))) unsigned char lds_raw[];
    LAS unsigned char* lds = (LAS unsigned char*)lds_raw;
    const int wave = __builtin_amdgcn_readfirstlane((int)threadIdx.x >> 6);
#define FRESH() const int lane = fresh_lane(); const int tid = wave * 64 + lane; (void)tid
    const int G = gridDim.x, bx = blockIdx.x; const int vcu = (G % 8 == 0) ? (bx % 8) * (G / 8) + bx / 8 : bx;
    const int gw = vcu * NWAVES + wave, NGW = G * NWAVES;
    cg::grid_group grid = cg::this_grid();
    const int lo = args.ph_lo, hi = args.ph_hi; int nbar = 0;
#ifndef PH_ONLY
#define PH_ONLY -1
#endif
#define IN(k) ((PH_ONLY < 0 || PH_ONLY == (k)) && lo <= (k) && (k) < hi)
#define REPS(k) _Pragma("nounroll") for (int rep_ = 0, nrep_ = opaque_i(((PROBE_REP >> (k)) & 1) ? 2 : 1); rep_ < nrep_; ++rep_)
#define SEAM(k) do { if (IN(k) && IN((k) + 1)) { if ((k) == 0) grid.sync(); else { ++nbar; \
        asm volatile("s_waitcnt vmcnt(0) lgkmcnt(0)" ::: "memory"); __syncthreads(); \
        if (wave == 0) { if (fresh_lane() == 0) { unsigned* ctr = (unsigned*)(args.ws + WS_BAR); \
            __builtin_amdgcn_fence(__ATOMIC_RELEASE, "agent"); asm volatile("s_waitcnt vmcnt(0)" ::: "memory"); \
            __hip_atomic_fetch_add(ctr, 1u, __ATOMIC_RELAXED, __HIP_MEMORY_SCOPE_AGENT); \
            const unsigned want = (unsigned)G * (unsigned)nbar; \
            while (__hip_atomic_load(ctr, __ATOMIC_RELAXED, __HIP_MEMORY_SCOPE_AGENT) < want) __builtin_amdgcn_s_sleep(2); \
            __builtin_amdgcn_fence(__ATOMIC_ACQUIRE, "agent"); asm volatile("s_waitcnt vmcnt(0)" ::: "memory"); } } \
        __syncthreads(); } } } while (0)
    unsigned char* ws = args.ws;
    const float* mod = (const float*)(ws + WS_MOD); const float* modf = (const float*)(ws + WS_MODF);
    bf16* Hb = (bf16*)(ws + WS_H);

    if (IN(0)) REPS(0) { FRESH(); p0_prologue(args, lds, vcu, G, tid, wave, lane); }
    SEAM(0);
    if (IN(1)) REPS(1) { FRESH(); norm_mod_rows<false>(args.in[I_XP], args.in[I_XS], nullptr, nullptr, args.in[I_GMIX], mod + 0, mod + 2048, 12288, Hb, gw, NGW, lane); }
    SEAM(1);
    if (IN(2)) {
        pg8::Gemm g{Hb, (const bf16*)(ws + WS_WIN), MROWS, NIN, D}; pg8::StaticOrder S; S.init(MROWS, NIN, D, G, bx, ((PROBE_REP >> 2) & 1) + 1);
        pg8::EpiIn E{(bf16*)(ws + WS_U), (bf16*)(ws + WS_G), (bf16*)(ws + WS_Q), (bf16*)(ws + WS_K), (bf16*)(ws + WS_V), args.out};
        pg8::gemm_phase<pg8::EpiIn, pg8::StaticOrder, true, true>(lds, g, S, E, wave);
    }
    SEAM(2);
    if (IN(3)) {
        LAS float* bt = (LAS float*)(lds + BT_OFF);
        __syncthreads();
        { FRESH(); bias_table(args, bt, tid); }
        __syncthreads();
        REPS(10) for (int v = vcu; v < 256; v += G) {
#ifndef NO_SMALL
            { FRESH(); sattn_unit(args, lds, bt, v >> 4, (v >> 1) & 7, v & 1, tid, wave, lane); }
            { FRESH(); sgate_unit(args, lds, v, tid, wave, lane); } if (v >= 240) { FRESH(); sgate_unit(args, lds, 256 + (v - 240), tid, wave, lane); }
#endif
        }
        __syncthreads();
        REPS(11) for (int v = vcu; v < 256; v += G) {
            const int combo = v >> 3, j = v & 7; const int b = combo >> 4, hh = combo & 15;
#pragma nounroll
            for (int i = 0; i < 8; ++i) { const int x = 8 * (i >> 1) + j; int qb = (i & 1) ? 63 - x : x; int b_ = b, hh_ = hh; asm volatile("" : "+s"(qb), "+s"(b_), "+s"(hh_));
#ifndef NO_ATTN
                attn_body::attn_unit<8>(b_, hh_, qb, (const attn_body::bf16*)(ws + WS_Q), (const attn_body::bf16*)(ws + WS_K), (const attn_body::bf16*)(ws + WS_V), (attn_body::bf16*)(ws + WS_O), (char*)lds_raw, (attn_body::lds_cfptr)(bt + (hh_ >> 1) * 196), wave);
#endif
            }
        }
    }
    SEAM(3);
    if (IN(4)) REPS(4) { FRESH(); const float lam = diff_lambda(args, lane); combine_rows(args, lam, gw, NGW, lane); }
    SEAM(4);
    if (IN(5)) {
        pg8::Gemm g{(const bf16*)(ws + WS_CAT), (const bf16*)(ws + WS_WOUT), MROWS, D, D}; pg8::StaticOrder S; S.init(MROWS, D, D, G, bx, 1, 4);
        pg8::EpiRes E{args.in[I_XP], nullptr, (bf16*)(ws + WS_X1B), mod + 4096, (float*)(ws + WS_PART)};
        pg8::gemm_phase<pg8::EpiRes, pg8::StaticOrder, true, true>(lds, g, S, E, wave);
    }
    SEAM(5);
    if (IN(6)) REPS(6) { FRESH(); norm_mod_rows<false>(nullptr, args.in[I_XS], (const bf16*)(ws + WS_X1B), nullptr, args.in[I_GFFN], mod + 6144, mod + 8192, 12288, Hb, gw, NGW, lane, (const float*)(ws + WS_PART), (bf16*)(ws + WS_X1B)); }
    SEAM(6);
    if (IN(7)) {
        pg8::Gemm g{Hb, (const bf16*)(ws + WS_WFI), MROWS, 2 * DFF, D}; pg8::StaticOrder S; S.init(MROWS, 2 * DFF, D, G, bx, ((PROBE_REP >> 7) & 1) + 1);
        pg8::EpiGlu E{(bf16*)(ws + WS_F)};
        pg8::gemm_phase<pg8::EpiGlu, pg8::StaticOrder, true, true>(lds, g, S, E, wave);
    }
    SEAM(7);
    if (IN(8)) {
        pg8::Gemm g{(const bf16*)(ws + WS_F), (const bf16*)(ws + WS_WFO), MROWS, D, DFF}; pg8::StaticOrder S; S.init(MROWS, D, DFF, G, bx, 1, 4);
        pg8::EpiRes E{nullptr, (const bf16*)(ws + WS_X1B), (bf16*)(ws + WS_X2B), mod + 10240, (float*)(ws + WS_PART)};
        pg8::gemm_phase<pg8::EpiRes, pg8::StaticOrder, true, true>(lds, g, S, E, wave);
    }
    SEAM(8);
    if (IN(9)) { FRESH(); norm_mod_rows<true>(nullptr, nullptr, (const bf16*)(ws + WS_X2B), (const bf16*)(ws + WS_X1B), args.in[I_GFIN], modf + 0, modf + 2048, 4096, args.out + OUT_Y, gw, NGW, lane, (const float*)(ws + WS_PART), nullptr); }
#undef IN
#undef SEAM
}

#ifndef MK_ONE_LAUNCH
#define MK_ONE_LAUNCH 1
#endif
extern "C" void kernel_launch(void* const* d_in, const int* in_sizes, int n_in, void* d_out, int out_size, void* d_ws, size_t ws_size, hipStream_t stream) {
    static int grid = 0;
    if (grid == 0) {
        if (n_in != 27 || ws_size < WS_END) { fprintf(stderr, "kernel_launch: unexpected inputs (n_in %d, ws %zu)\n", n_in, ws_size); grid = -1; return; }
        int dev = 0, cus = 0, per_cu = 0;
        hipGetDevice(&dev); hipDeviceGetAttribute(&cus, hipDeviceAttributeMultiprocessorCount, dev);
        if (hipFuncSetAttribute((const void*)fwd_megakernel, hipFuncAttributeMaxDynamicSharedMemorySize, LDS_BYTES) != hipSuccess) { fprintf(stderr, "kernel_launch: hipFuncSetAttribute failed\n"); grid = -1; return; }
        if (hipOccupancyMaxActiveBlocksPerMultiprocessor(&per_cu, (const void*)fwd_megakernel, NTHR, LDS_BYTES) != hipSuccess || per_cu < 1) per_cu = 1;
        (void)hipGetLastError();
        grid = cus * per_cu; if (grid <= 0) grid = 256;
    }
    if (grid < 0) return;
    Args a{};
    for (int i = 0; i < 27; ++i) a.in[i] = (const float*)d_in[i];
    a.out = (float*)d_out; a.ws = (unsigned char*)d_ws;
#if MK_ONE_LAUNCH
    a.ph_lo = 0; a.ph_hi = NPH;
    (void)hipMemsetAsync((unsigned char*)d_ws + WS_BAR, 0, 256, stream);
    void* kargs[] = {&a};
    hipError_t e = hipLaunchCooperativeKernel((const void*)fwd_megakernel, dim3(grid), dim3(NTHR), kargs, LDS_BYTES, stream);
    if (e != hipSuccess) fprintf(stderr, "cooperative launch failed: %s (grid %d)\n", hipGetErrorString(e), grid);
#else
    for (int p = 0; p < NPH; ++p) { a.ph_lo = p; a.ph_hi = p + 1; hipLaunchKernelGGL(fwd_megakernel, dim3(grid), dim3(NTHR), LDS_BYTES, stream, a); }
#endif
}
```

```cpp
#include <hip/hip_runtime.h>
#include <hip/hip_bf16.h>
#include <hip/hip_cooperative_groups.h>
#include <cstdio>
#include <cstdint>
#include <cmath>
namespace cg = cooperative_groups;
#ifndef PROBE_REP
#define PROBE_REP 0
#endif
__device__ __forceinline__ int opaque_i(int v) { asm volatile("" : "+s"(v)); return v; }
__device__ __forceinline__ int fresh_lane() { int l; asm volatile("v_mbcnt_lo_u32_b32 %0, -1, 0\n\tv_mbcnt_hi_u32_b32 %0, -1, %0" : "=v"(l)); return l; }
namespace pg8 {
#define PG8_LAS __attribute__((address_space(3)))
typedef unsigned short bf16_t;
typedef short bf16x8 __attribute__((ext_vector_type(8)));
typedef float f32x4 __attribute__((ext_vector_type(4)));
typedef unsigned u32x4 __attribute__((ext_vector_type(4)));
constexpr int BM = 256, BK = 64, HALF = 128, HTB = HALF * BK * 2  , STAGE_BYTES = 8 * HTB, NXCD = 8, WGM = 8;

__host__ __device__ __forceinline__ int lds_byte(int r, int c) { const int st = (r >> 4) * 2 + (c >> 5), rr = r & 15, cc = c & 31, ob = rr * 64 + cc * 2; return st * 1024 + (ob ^ (((ob >> 9) & 1) << 5)); }
__host__ __device__ __forceinline__ void stage_rc(int b, int& R, int& C) { const int st = b / 1024, sb = b % 1024, swz = sb ^ (((sb >> 9) & 1) << 5); R = (st >> 1) * 16 + swz / 64; C = (st & 1) * 32 + (swz % 64) / 2; }
__host__ __device__ __forceinline__ int perm32(int rho) { const int n = rho >> 4, i = rho & 15; return 8 * (i >> 2) + 4 * n + (i & 3); }

struct Unit { int pm, pn, k0, nt, split; };
struct Gemm { const bf16_t* A; const bf16_t* Bt; int M, N, K; };

struct StaticOrder {
    int nM, nN, nwg, G, c, rep, ntk, nsplit, nMmain;
    __host__ __device__ void init(int M, int N, int K, int G_, int c_, int rep_ = 1, int nsplit_ = 0) { nM = M / BM; nN = N / BM; G = G_; c = c_; rep = rep_; ntk = K / BK; nsplit = nsplit_;
        nMmain = nsplit_ > 0 ? 128 : nM; nwg = nMmain * nN; }
    __host__ __device__ bool next(int i, Unit& u) const {
        const long L = (long)i * G + c; u.k0 = 0; u.nt = ntk; u.split = 0;
        if (nsplit > 0 && L >= nwg) { const int s = (int)(L - nwg); if (s >= (nM - nMmain) * nN * nsplit) return false;
            const int tile = s / nsplit, ks = s % nsplit; u.pm = nMmain + tile / nN; u.pn = tile % nN; u.nt = ntk / nsplit; u.k0 = ks * u.nt; u.split = 1; return true; }
        if (L >= (long)nwg * rep) return false;
        int wgid = (int)(L % nwg); { const int q = nwg / NXCD, r = nwg % NXCD, xcd = wgid % NXCD, off = wgid / NXCD; wgid = (xcd < r ? xcd * (q + 1) : r * (q + 1) + (xcd - r) * q) + off; }
        const int nig = WGM * nN, gid = wgid / nig, fm = gid * WGM, gsz = (nMmain - fm) < WGM ? (nMmain - fm) : WGM;
        u.pm = fm + ((wgid % nig) % gsz); u.pn = (wgid % nig) / gsz; return true;
    }
    __device__ __forceinline__ void a_ready(const Unit&) const {}
    __device__ __forceinline__ void done(const Unit&) const {}
};

__device__ __forceinline__ unsigned cvt_pk_bf16(float lo, float hi) { unsigned r; asm volatile("v_cvt_pk_bf16_f32 %0, %1, %2" : "=v"(r) : "v"(lo), "v"(hi)); return r; }
typedef float f32x2 __attribute__((ext_vector_type(2)));
constexpr int MROWS = 33792, MP = 32768;
constexpr long OUT_Y = 0, OUT_KP = 69206016L, OUT_VP = 102760448L, OUT_KS = 136314880L, OUT_VS = 137363456L, OUT_GVS = 138412032L;
__device__ __forceinline__ int row_batch(int row) { return row < MP ? (row >> 14) : 2 + ((row - MP) >> 6); }
__device__ __forceinline__ float gelu_tanh(float x) { const float u = 0.7978845608028654f * (x + 0.044715f * x * x * x); const float e = __builtin_amdgcn_exp2f(-2.8853900817779268f * u); return x * __builtin_amdgcn_rcpf(1.0f + e); }
__device__ __forceinline__ float silu_f(float x) { const float e = __builtin_amdgcn_exp2f(-1.4426950408889634f * x); return x * __builtin_amdgcn_rcpf(1.0f + e); }
__device__ __forceinline__ u32x4 pack8(f32x4 v0, f32x4 v1) { u32x4 w; w.x = cvt_pk_bf16(v0[0], v0[1]); w.y = cvt_pk_bf16(v0[2], v0[3]); w.z = cvt_pk_bf16(v1[0], v1[1]); w.w = cvt_pk_bf16(v1[2], v1[3]); return w; }

struct EpiIn {
    static constexpr bool PERM = true, AFTER_DRAIN = false;
    bf16_t *U, *G, *Q, *Kb, *Vb; float* out;
    __device__ __forceinline__ void operator()(const f32x4 (&acc)[2][2][4][2], const Unit& u, int wr, int wc, int fr, int fq) const {
        const int seg = u.pn >> 2, colt = (u.pn & 3) * BM;
        const int row0 = u.pm * BM + wr * 64 + fr, col0 = colt + wc * 32 + 8 * fq;
        bf16_t* dst = seg == 0 ? U : seg == 1 ? G : seg == 2 ? Q : seg == 3 ? Kb : Vb;
#pragma unroll
        for (int ai = 0; ai < 2; ++ai)
#pragma unroll
            for (int m = 0; m < 4; ++m) { const int row = row0 + ai * HALF + m * 16;
#pragma unroll
                for (int bj = 0; bj < 2; ++bj) { f32x4 v0 = acc[ai][bj][m][0], v1 = acc[ai][bj][m][1]; const int col = col0 + bj * HALF;
                    if (seg < 2) {
#pragma unroll
                        for (int e = 0; e < 4; ++e) { v0[e] = gelu_tanh(v0[e]); v1[e] = gelu_tanh(v1[e]); }
                    } else if (seg == 2) { v0 = v0 * 0.18033688011112042f; v1 = v1 * 0.18033688011112042f; }
                    else { float* o = (row < MP) ? out + (seg == 3 ? OUT_KP : OUT_VP) + (size_t)row * 1024 + col : out + (seg == 3 ? OUT_KS : OUT_VS) + (size_t)(row - MP) * 1024 + col;
                        *(f32x4*)o = v0; *(f32x4*)(o + 4) = v1; }
                    *(u32x4*)(dst + (size_t)row * 1024 + col) = pack8(v0, v1); } }
    }
};
struct EpiRes {
    static constexpr bool PERM = true, AFTER_DRAIN = false;
    const float* xp; const bf16_t* baseb; bf16_t* outb; const float* gate; float* part;
    __device__ __forceinline__ void operator()(const f32x4 (&acc)[2][2][4][2], const Unit& u, int wr, int wc, int fr, int fq) const {
        const int row0 = u.pm * BM + wr * 64 + fr, col0 = u.pn * BM + wc * 32 + 8 * fq;
#pragma unroll
        for (int ai = 0; ai < 2; ++ai) {
            const int b = row_batch(u.pm * BM + ai * HALF + wr * 64);
            const float* gt = gate + (size_t)b * 12288 + col0;
            f32x4 g[2][2];
#pragma unroll
            for (int bj = 0; bj < 2; ++bj) { g[bj][0] = *(const f32x4*)(gt + bj * HALF); g[bj][1] = *(const f32x4*)(gt + bj * HALF + 4); }
#pragma unroll
            for (int m = 0; m < 4; ++m) { const int row = row0 + ai * HALF + m * 16;
#pragma unroll
                for (int bj = 0; bj < 2; ++bj) { const int col = col0 + bj * HALF;
                    if (u.split) { float* pp = part + ((size_t)(u.k0 / u.nt) * (MROWS - MP) + (size_t)(row - MP)) * 2048 + col;
                        *(f32x4*)pp = g[bj][0] * acc[ai][bj][m][0]; *(f32x4*)(pp + 4) = g[bj][1] * acc[ai][bj][m][1];
                    } else {
                        f32x4 b0, b1;
                        if (xp) { const float* src = xp + (size_t)row * 2048 + col; b0 = *(const f32x4*)src; b1 = *(const f32x4*)(src + 4); }
                        else { const u32x4 w = *(const u32x4*)(baseb + (size_t)row * 2048 + col);
                            b0 = (f32x4){__builtin_bit_cast(float, w.x << 16), __builtin_bit_cast(float, w.x & 0xffff0000u), __builtin_bit_cast(float, w.y << 16), __builtin_bit_cast(float, w.y & 0xffff0000u)};
                            b1 = (f32x4){__builtin_bit_cast(float, w.z << 16), __builtin_bit_cast(float, w.z & 0xffff0000u), __builtin_bit_cast(float, w.w << 16), __builtin_bit_cast(float, w.w & 0xffff0000u)}; }
                        *(u32x4*)(outb + (size_t)row * 2048 + col) = pack8(b0 + g[bj][0] * acc[ai][bj][m][0], b1 + g[bj][1] * acc[ai][bj][m][1]); } } }
        }
    }
};
struct EpiGlu {
    static constexpr bool PERM = true, AFTER_DRAIN = false;
    bf16_t* F;
    __device__ __forceinline__ void operator()(const f32x4 (&acc)[2][2][4][2], const Unit& u, int wr, int wc, int fr, int fq) const {
        const int row0 = u.pm * BM + wr * 64 + fr, col0 = u.pn * HALF + wc * 32 + 8 * fq;
#pragma unroll
        for (int ai = 0; ai < 2; ++ai)
#pragma unroll
            for (int m = 0; m < 4; ++m) { const int row = row0 + ai * HALF + m * 16;
                f32x4 v0, v1;
#pragma unroll
                for (int e = 0; e < 4; ++e) { v0[e] = silu_f(acc[ai][0][m][0][e]) * acc[ai][1][m][0][e]; v1[e] = silu_f(acc[ai][0][m][1][e]) * acc[ai][1][m][1][e]; }
                *(u32x4*)(F + (size_t)row * 5632 + col0) = pack8(v0, v1); }
    }
};

template <class Epi, class Sched, bool ALIGN_EPI = false, bool SP2 = false>
__device__ __forceinline__ void gemm_phase(PG8_LAS unsigned char* lds, const Gemm g, const Sched& S, const Epi& E, const int wid_in) {
    const int wid = wid_in, lane = fresh_lane(), tid = wid * 64 + lane, wr = wid >> 2, wc = wid & 3, fr = lane & 15, fq = lane >> 4;
    const int K = g.K;
    unsigned voffA[2], voffB[2];
#pragma unroll
    for (int i = 0; i < 2; ++i) { int R, C; stage_rc(tid * 16 + i * 8192, R, C); const int Rb = Epi::PERM ? ((R & ~31) + perm32(R & 31)) : R;
        voffA[i] = (unsigned)(R * K + C) * 2u; voffB[i] = (unsigned)(Rb * K + C) * 2u; }
    const size_t kstep = (size_t)(BK * 2);
    const size_t hstep = (size_t)HALF * K * 2;
    const size_t tstep = 2 * hstep;
    const unsigned ldsw = (unsigned)wid * 1024u;
    const int aoff = lds_byte(wr * 64 + fr, fq * 8), boff = lds_byte(wc * 32 + fr, fq * 8);
#define PG8_SA(b, h) (((b) * 2 + (h)) * HTB)
#define PG8_SB(b, h) ((4 + (b) * 2 + (h)) * HTB)
#define PG8_STAGE(bufoff, gbase, voff) do { _Pragma("unroll") for (int _i = 0; _i < 2; ++_i) \
        __builtin_amdgcn_global_load_lds((const unsigned*)((const char*)(gbase) + (voff)[_i]), (PG8_LAS unsigned*)(lds + (bufoff) + ldsw + _i * 8192), 16, 0, 0); } while (0)
#define PG8_LDA(dst, b, h) do { _Pragma("unroll") for (int m = 0; m < 4; ++m) _Pragma("unroll") for (int k = 0; k < 2; ++k) dst[m][k] = *(const PG8_LAS bf16x8*)(lds + PG8_SA(b, h) + aoff + m * 2048 + k * 1024); } while (0)
#define PG8_LDB(dst, b, h) do { _Pragma("unroll") for (int n = 0; n < 2; ++n) _Pragma("unroll") for (int k = 0; k < 2; ++k) dst[n][k] = *(const PG8_LAS bf16x8*)(lds + PG8_SB(b, h) + boff + n * 2048 + k * 1024); } while (0)
#define PG8_MMA(ai, bj, At, Bt) do { __builtin_amdgcn_s_setprio(1); _Pragma("unroll") for (int m = 0; m < 4; ++m) _Pragma("unroll") for (int n = 0; n < 2; ++n) _Pragma("unroll") for (int k = 0; k < 2; ++k) \
        acc[ai][bj][m][n] = __builtin_amdgcn_mfma_f32_16x16x32_bf16(Bt[n][k], At[m][k], acc[ai][bj][m][n], 0, 0, 0); __builtin_amdgcn_s_setprio(0); } while (0)
#define PG8_WAIT_V(n) asm volatile("s_waitcnt vmcnt(" #n ")" ::: "memory")
#define PG8_WAIT_L(n) asm volatile("s_waitcnt lgkmcnt(" #n ")" ::: "memory")
#define PG8_BAR __builtin_amdgcn_s_barrier()
#define PG8_SCHED __builtin_amdgcn_sched_barrier(0)
    Unit cur, nxt; int ui = 0;
    if (!S.next(0, cur)) return;
    f32x4 acc[2][2][4][2];
#pragma unroll
    for (int a = 0; a < 2; ++a)
#pragma unroll
        for (int b = 0; b < 2; ++b)
#pragma unroll
            for (int m = 0; m < 4; ++m)
#pragma unroll
                for (int n = 0; n < 2; ++n) acc[a][b][m][n] = (f32x4){0.f, 0.f, 0.f, 0.f};
    bf16x8 At[4][2], B0[2][2], B1[2][2];
    const char* cA = (const char*)g.A + (size_t)cur.pm * tstep + (size_t)cur.k0 * kstep; const char* cB = (const char*)g.Bt + (size_t)cur.pn * tstep + (size_t)cur.k0 * kstep;
    int nt = cur.nt;
    S.a_ready(cur);
    if constexpr (SP2) {
        PG8_STAGE(PG8_SB(0, 0), cB, voffB); PG8_STAGE(PG8_SB(0, 1), cB + hstep, voffB); PG8_STAGE(PG8_SA(0, 0), cA, voffA); PG8_STAGE(PG8_SA(0, 1), cA + hstep, voffA);
        if (wr == 1) PG8_BAR;
        PG8_WAIT_V(2); PG8_BAR;
        PG8_STAGE(PG8_SB(1, 0), cB + kstep, voffB); PG8_STAGE(PG8_SA(1, 0), cA + kstep, voffA); PG8_STAGE(PG8_SB(1, 1), cB + hstep + kstep, voffB);
        PG8_WAIT_V(6); PG8_BAR;
    } else {
        PG8_STAGE(PG8_SB(0, 0), cB, voffB); PG8_STAGE(PG8_SA(0, 0), cA, voffA); PG8_STAGE(PG8_SB(0, 1), cB + hstep, voffB); PG8_STAGE(PG8_SA(0, 1), cA + hstep, voffA);
        if (wr == 1) PG8_BAR;
        PG8_WAIT_V(4); PG8_BAR;
        PG8_STAGE(PG8_SB(1, 0), cB + kstep, voffB); PG8_STAGE(PG8_SA(1, 0), cA + kstep, voffA); PG8_STAGE(PG8_SB(1, 1), cB + hstep + kstep, voffB);
        PG8_WAIT_V(6); PG8_BAR;
    }
    for (;;) {
        const bool has_next = S.next(ui + 1, nxt);
        const char* nA = has_next ? (const char*)g.A + (size_t)nxt.pm * tstep + (size_t)nxt.k0 * kstep : cA; const char* nB = has_next ? (const char*)g.Bt + (size_t)nxt.pn * tstep + (size_t)nxt.k0 * kstep : cB;
        for (int t = 0; t < nt; t += 2) {
            const bool last = (t == nt - 2);
            const char* a1 = cA + (size_t)(t + 1) * kstep;
            const char* a2 = last ? nA : cA + (size_t)(t + 2) * kstep; const char* b2 = last ? nB : cB + (size_t)(t + 2) * kstep;
            const char* a3 = a2 + kstep; const char* b3 = b2 + kstep;
            if (last && has_next) S.a_ready(nxt);
            if constexpr (SP2) {
            PG8_LDB(B0, 0, 0); PG8_LDB(B1, 0, 1); PG8_SCHED; PG8_LDA(At, 0, 0); PG8_STAGE(PG8_SA(1, 1), a1 + hstep, voffA);
            PG8_WAIT_V(8); PG8_WAIT_L(0); PG8_BAR; PG8_MMA(0, 0, At, B0); PG8_MMA(0, 1, At, B1); PG8_BAR; PG8_SCHED;
            PG8_LDA(At, 0, 1); PG8_STAGE(PG8_SB(0, 0), b2, voffB); PG8_STAGE(PG8_SB(0, 1), b2 + hstep, voffB); PG8_STAGE(PG8_SA(0, 0), a2, voffA);
            PG8_WAIT_V(8); PG8_WAIT_L(0); PG8_BAR; PG8_MMA(1, 0, At, B0); PG8_MMA(1, 1, At, B1); PG8_BAR; PG8_SCHED;
            PG8_LDB(B0, 1, 0); PG8_LDB(B1, 1, 1); PG8_SCHED; PG8_LDA(At, 1, 0); PG8_STAGE(PG8_SA(0, 1), a2 + hstep, voffA);
            PG8_WAIT_V(8); PG8_WAIT_L(0); PG8_BAR; PG8_MMA(0, 0, At, B0); PG8_MMA(0, 1, At, B1); PG8_BAR; PG8_SCHED;
            PG8_LDA(At, 1, 1); PG8_STAGE(PG8_SB(1, 0), b3, voffB); PG8_STAGE(PG8_SB(1, 1), b3 + hstep, voffB); PG8_STAGE(PG8_SA(1, 0), a3, voffA);
            PG8_WAIT_V(8); PG8_WAIT_L(0); PG8_BAR; PG8_MMA(1, 0, At, B0); PG8_MMA(1, 1, At, B1); PG8_BAR; PG8_SCHED;
            } else {
            PG8_LDB(B0, 0, 0); PG8_SCHED; PG8_LDA(At, 0, 0); PG8_STAGE(PG8_SA(1, 1), a1 + hstep, voffA);
            PG8_WAIT_L(8); PG8_BAR; PG8_WAIT_L(0); PG8_MMA(0, 0, At, B0); PG8_BAR; PG8_SCHED;
            PG8_LDB(B1, 0, 1); PG8_STAGE(PG8_SB(0, 0), b2, voffB);
            PG8_BAR; PG8_WAIT_L(0); PG8_MMA(0, 1, At, B1); PG8_BAR;
            PG8_LDA(At, 0, 1); PG8_STAGE(PG8_SA(0, 0), a2, voffA);
            PG8_BAR; PG8_WAIT_L(0); PG8_MMA(1, 0, At, B0); PG8_BAR; PG8_SCHED;
            PG8_STAGE(PG8_SB(0, 1), b2 + hstep, voffB);
            PG8_WAIT_V(6); PG8_BAR; PG8_MMA(1, 1, At, B1); PG8_BAR;
            PG8_LDB(B0, 1, 0); PG8_SCHED; PG8_LDA(At, 1, 0); PG8_STAGE(PG8_SA(0, 1), a2 + hstep, voffA);
            PG8_WAIT_L(8); PG8_BAR; PG8_WAIT_L(0); PG8_MMA(0, 0, At, B0); PG8_BAR; PG8_SCHED;
            PG8_LDB(B1, 1, 1); PG8_STAGE(PG8_SB(1, 0), b3, voffB);
            PG8_BAR; PG8_WAIT_L(0); PG8_MMA(0, 1, At, B1); PG8_BAR;
            PG8_LDA(At, 1, 1); PG8_STAGE(PG8_SA(1, 0), a3, voffA);
            PG8_BAR; PG8_WAIT_L(0); PG8_MMA(1, 0, At, B0); PG8_BAR; PG8_SCHED;
            PG8_STAGE(PG8_SB(1, 1), b3 + hstep, voffB);
            PG8_WAIT_V(6); PG8_BAR; PG8_MMA(1, 1, At, B1); PG8_BAR;
            }
        }
        if constexpr (ALIGN_EPI) { if (wr == 0) PG8_BAR; }
        if constexpr (!Epi::AFTER_DRAIN) { E(acc, cur, wr, wc, fr, fq); S.done(cur); }
        if (!has_next) break;
#pragma unroll
        for (int a = 0; a < 2; ++a)
#pragma unroll
            for (int b = 0; b < 2; ++b)
#pragma unroll
                for (int m = 0; m < 4; ++m)
#pragma unroll
                    for (int n = 0; n < 2; ++n) acc[a][b][m][n] = (f32x4){0.f, 0.f, 0.f, 0.f};
        cur = nxt; cA = nA; cB = nB; ++ui; nt = cur.nt;
        if constexpr (ALIGN_EPI) { if (wr == 1) PG8_BAR; }
    }
    PG8_WAIT_V(0);
    if constexpr (!ALIGN_EPI) { if (wr == 0) PG8_BAR; }
    PG8_BAR;
    if constexpr (Epi::AFTER_DRAIN) { E.fused(acc, cur, wr, wc, fr, fq, lds, wid, lane); S.done(cur); }
#undef PG8_SA
#undef PG8_SB
#undef PG8_STAGE
#undef PG8_LDA
#undef PG8_LDB
#undef PG8_MMA
#undef PG8_WAIT_V
#undef PG8_WAIT_L
#undef PG8_BAR
#undef PG8_SCHED
}
}
namespace attn_body {
using bf16=__hip_bfloat16;
using bf16x8=__attribute__((ext_vector_type(8)))short;
using s16x4=__attribute__((ext_vector_type(4)))short;
using f32x16=__attribute__((ext_vector_type(16)))float;
using u32x4=__attribute__((ext_vector_type(4)))unsigned;
constexpr int BATCH=2,NHEAD=16,SEQ=16384,D=64,DM=NHEAD*D,ODM=2048;
constexpr int NW=8,NA=4,QBLK=32,QB=QBLK*NW,KVBLK=64,NQB=SEQ/QB;
constexpr int ATTN_PITCH=DM, ATTN_UNIT_ROWS=QB;
__device__ __forceinline__ int crow(int r,int hi){return (r&3)+8*(r>>2)+4*hi;}
#define SBAR() __builtin_amdgcn_sched_barrier(0)
typedef __attribute__((address_space(3))) const float* lds_cfptr;
#ifndef CM_VAR
#define CM_VAR 0
#endif
#ifndef CM_GRP
#define CM_GRP 16
#endif
__device__ __forceinline__ int med3i(int a,int lo,int hi){ return a<lo?lo:(a>hi?hi:a); }
__device__ __forceinline__ void cmask(f32x16&p0,f32x16&p1,int jb,int qrel,int hi,lds_cfptr bt){
  const float NEG=-INFINITY;
#if CM_VAR==0
  const int kb=64*jb+4*hi; const int qlim=(qrel|63)-kb; const int base=kb-qrel+128;
  #pragma unroll
  for(int r=0;r<16;++r){const int ko=(r&3)+8*(r>>2);
    const float b0=bt[med3i(base+ko,0,192)], b1=bt[med3i(base+ko+32,0,192)];
    p0[r]=(ko>qlim)?NEG:p0[r]+b0; p1[r]=(ko+32>qlim)?NEG:p1[r]+b1;
    if((r%CM_GRP)==CM_GRP-1)__builtin_amdgcn_sched_barrier(0); }
#elif CM_VAR==1
  int kb=64*jb+4*hi; const int ql=qrel|63;
  #pragma unroll
  for(int r=0;r<16;++r){int kv=kb+(r&3)+8*(r>>2); if(kv>ql)p0[r]=NEG; if(kv+32>ql)p1[r]=NEG;}
#elif CM_VAR==2
  lds_cfptr bp = bt + (64*jb+4*hi-qrel+320); const int qlim=(qrel|63)-(64*jb+4*hi);
  #pragma unroll
  for(int r=0;r<16;++r){const int ko=(r&3)+8*(r>>2);
    const float b0=bp[ko], b1=bp[ko+32];
    p0[r]=(ko>qlim)?NEG:p0[r]+b0; p1[r]=(ko+32>qlim)?NEG:p1[r]+b1;
    if((r&3)==3)__builtin_amdgcn_sched_barrier(0); }
#endif
}

constexpr int NSLOT=3, SLOTB=8192;
constexpr int VSLOTB=2*SLOTB;
constexpr int NVSLOT=4;
constexpr int LDS_K=0, LDS_V=NSLOT*SLOTB, LDS_WS=LDS_V+NVSLOT*VSLOTB, LDS_BYTES=LDS_WS+NW*64*4;
constexpr float C2=0.125f*1.4426950408889634f;
__device__ __forceinline__ void glds16(const void*gsrc,unsigned lds_dst){unsigned keep;
  asm volatile("s_mov_b32 %0, m0\n\ts_mov_b32 m0, %2\n\ts_nop 0\n\tglobal_load_lds_dwordx4 %1, off\n\ts_mov_b32 m0, %0":"=&s"(keep):"v"(gsrc),"s"(lds_dst):"memory");}
__device__ __forceinline__ float max3f(float a,float b,float c){float r;asm("v_max3_f32 %0, %1, %2, %3":"=v"(r):"v"(a),"v"(b),"v"(c));return r;}
__device__ __forceinline__ float max2f(float a,float b){float r;asm("v_max_f32_e32 %0, %1, %2":"=v"(r):"v"(a),"v"(b));return r;}
__device__ __forceinline__ float fadd_s(float a,float b){float r;asm("v_add_f32_e32 %0, %1, %2":"=v"(r):"v"(a),"v"(b));return r;}
__device__ __forceinline__ float fsub_s(float a,float b){float r;asm("v_sub_f32_e32 %0, %1, %2":"=v"(r):"v"(a),"v"(b));return r;}
typedef float f32x2_t __attribute__((ext_vector_type(2))); typedef __bf16 bf16x2_t __attribute__((ext_vector_type(2)));
__device__ __forceinline__ unsigned cvtpk_s(float lo,float hi){f32x2_t v={lo,hi};bf16x2_t b=__builtin_convertvector(v,bf16x2_t);return __builtin_bit_cast(unsigned,b);}
#define WAIT_BAR(N) asm volatile("s_waitcnt vmcnt(" #N ") lgkmcnt(0)\n\ts_barrier":::"memory")

__device__ __forceinline__ void qkt(f32x16&p0,f32x16&p1,const char*Kslot,const bf16x8*qr,const f32x16&negm,int r32,int hi){
  const char*kb=Kslot+hi*1024+r32*16;
  #pragma unroll
  for(int d0=0;d0<4;++d0){
    const bf16x8 b0=*reinterpret_cast<const bf16x8*>(kb+d0*2048);
    const bf16x8 b1=*reinterpret_cast<const bf16x8*>(kb+d0*2048+512);
    if(d0==0){p0=__builtin_amdgcn_mfma_f32_32x32x16_bf16(b0,qr[0],negm,0,0,0);p1=__builtin_amdgcn_mfma_f32_32x32x16_bf16(b1,qr[0],negm,0,0,0);}
    else{p0=__builtin_amdgcn_mfma_f32_32x32x16_bf16(b0,qr[d0],p0,0,0,0);p1=__builtin_amdgcn_mfma_f32_32x32x16_bf16(b1,qr[d0],p1,0,0,0);}}
}
typedef __attribute__((address_space(3))) const char* lds_cptr;
typedef short v4i16_t __attribute__((ext_vector_type(4)));
__device__ __forceinline__ void kload8(bf16x8*kf,lds_cptr kp){
  kf[0]=*(const __attribute__((address_space(3))) bf16x8*)(kp);      kf[1]=*(const __attribute__((address_space(3))) bf16x8*)(kp+512);
  kf[2]=*(const __attribute__((address_space(3))) bf16x8*)(kp+2048); kf[3]=*(const __attribute__((address_space(3))) bf16x8*)(kp+2560);
  kf[4]=*(const __attribute__((address_space(3))) bf16x8*)(kp+4096); kf[5]=*(const __attribute__((address_space(3))) bf16x8*)(kp+4608);
  kf[6]=*(const __attribute__((address_space(3))) bf16x8*)(kp+6144); kf[7]=*(const __attribute__((address_space(3))) bf16x8*)(kp+6656);
}
__device__ __forceinline__ void kload2(bf16x8*kf,lds_cptr kp,int j){ kf[2*j]=*(const __attribute__((address_space(3))) bf16x8*)(kp+j*2048); kf[2*j+1]=*(const __attribute__((address_space(3))) bf16x8*)(kp+j*2048+512); }
__device__ __forceinline__ s16x4 vtr(lds_cptr p){ return __builtin_bit_cast(s16x4,__builtin_amdgcn_ds_read_tr16_b64_v4i16((__attribute__((address_space(3))) v4i16_t*)p)); }
__device__ __forceinline__ float rowmax(const f32x16&p0,const f32x16&p1){
  float a=max3f(p0[0],p0[1],p1[0]),b=max3f(p0[2],p0[3],p1[1]);a=max3f(a,p1[2],p1[3]);
  #pragma unroll
  for(int r=4;r<16;r+=4){a=max3f(a,p0[r],p0[r+1]);b=max3f(b,p0[r+2],p0[r+3]);a=max3f(a,p1[r],p1[r+1]);b=max3f(b,p1[r+2],p1[r+3]);}
  const float m=max2f(a,b);
  auto rr=__builtin_amdgcn_permlane32_swap(__float_as_uint(m),__float_as_uint(m),false,false);
  return max2f(__uint_as_float(rr[0]),__uint_as_float(rr[1]));
}
__device__ __forceinline__ void pv(f32x16*o,int vb,bf16x8 pa0,bf16x8 pa1,bf16x8 pa2,bf16x8 pa3){
  #pragma unroll
  for(int d0=0;d0<2;++d0){s16x4 lo[4],hi[4];
    #pragma unroll
    for(int ks=0;ks<4;++ks){
      asm volatile("ds_read_b64_tr_b16 %0,%1 offset:%c2":"=&v"(lo[ks]):"v"(vb),"i"(d0*4096+ks*1024):"memory");
      asm volatile("ds_read_b64_tr_b16 %0,%1 offset:%c2":"=&v"(hi[ks]):"v"(vb),"i"(d0*4096+ks*1024+512):"memory");}
    asm volatile("s_waitcnt lgkmcnt(0)":::"memory");SBAR();
    #define PK(k) (bf16x8){lo[k][0],lo[k][1],lo[k][2],lo[k][3],hi[k][0],hi[k][1],hi[k][2],hi[k][3]}
    o[d0]=__builtin_amdgcn_mfma_f32_32x32x16_bf16(pa0,PK(0),o[d0],0,0,0);
    o[d0]=__builtin_amdgcn_mfma_f32_32x32x16_bf16(pa1,PK(1),o[d0],0,0,0);
    o[d0]=__builtin_amdgcn_mfma_f32_32x32x16_bf16(pa2,PK(2),o[d0],0,0,0);
    o[d0]=__builtin_amdgcn_mfma_f32_32x32x16_bf16(pa3,PK(3),o[d0],0,0,0);
    #undef PK
  }
}

__device__ __forceinline__ void pv4(f32x16*o,int vb,bf16x8 pa0,bf16x8 pa1,bf16x8 pa2,bf16x8 pa3){
  s16x4 lo[2][4],hi[2][4];
  #define RD8(set,ks) do{ _Pragma("unroll") for(int d0=0;d0<4;++d0){ \
      asm volatile("ds_read_b64_tr_b16 %0,%1 offset:%c2":"=&v"(lo[set][d0]):"v"(vb),"i"(d0*4096+(ks)*1024):"memory"); \
      asm volatile("ds_read_b64_tr_b16 %0,%1 offset:%c2":"=&v"(hi[set][d0]):"v"(vb),"i"(d0*4096+(ks)*1024+512):"memory");} }while(0)
  #define PK(set,k) (bf16x8){lo[set][k][0],lo[set][k][1],lo[set][k][2],lo[set][k][3],hi[set][k][0],hi[set][k][1],hi[set][k][2],hi[set][k][3]}
  #define MM4(set,pa) do{ o[0]=__builtin_amdgcn_mfma_f32_32x32x16_bf16(pa,PK(set,0),o[0],0,0,0); o[1]=__builtin_amdgcn_mfma_f32_32x32x16_bf16(pa,PK(set,1),o[1],0,0,0); \
      o[2]=__builtin_amdgcn_mfma_f32_32x32x16_bf16(pa,PK(set,2),o[2],0,0,0); o[3]=__builtin_amdgcn_mfma_f32_32x32x16_bf16(pa,PK(set,3),o[3],0,0,0); }while(0)
  RD8(0,0);
  RD8(1,1); asm volatile("s_waitcnt lgkmcnt(8)":::"memory"); SBAR(); MM4(0,pa0); SBAR();
  RD8(0,2); asm volatile("s_waitcnt lgkmcnt(8)":::"memory"); SBAR(); MM4(1,pa1); SBAR();
  RD8(1,3); asm volatile("s_waitcnt lgkmcnt(8)":::"memory"); SBAR(); MM4(0,pa2); SBAR();
  asm volatile("s_waitcnt lgkmcnt(0)":::"memory"); SBAR(); MM4(1,pa3);
  #undef RD8
  #undef PK
  #undef MM4
}
#ifndef ATTN_STORE16
#define ATTN_STORE16(p,v) (*(u32x4*)(p)=(v))
#endif
template<int THRL> __device__ __forceinline__ void attn_unit(int b,int h,int qb,const bf16*Q,const bf16*__restrict__ K,const bf16*__restrict__ V,bf16*O,char*shm,lds_cfptr bt,const int wid_in){
  const int wid=wid_in,lane=fresh_lane(),r32=lane&31,hi=lane>>5;
  const long rowbase=(long)b*SEQ; const int q0=qb*QB;
  const bf16*Kh=K+rowbase*DM+h*D,*Vh=V+rowbase*DM+(h>>1)*128;
  const unsigned lds0=(unsigned)(uintptr_t)shm;
  const bf16*ksrc=Kh+(long)lane*DM+wid*8;
  const bf16*vsrc=Vh+(long)(16*(wid&3)+(lane>>2))*DM+(wid>>2)*32+(lane&3)*8;
  const unsigned kdst=lds0+LDS_K+wid*1024, vdst=lds0+LDS_V+wid*1024;
  #define DMA_K(t,slot) glds16(ksrc+(long)(t)*KVBLK*DM,(unsigned)__builtin_amdgcn_readfirstlane(kdst+(slot)))
  #define VOFF(t) ((int)(((t)&(NVSLOT-1))*VSLOTB))
  #define DMA_V(t) do{ glds16(vsrc+(long)(t)*KVBLK*DM,(unsigned)__builtin_amdgcn_readfirstlane(vdst+VOFF(t))); glds16(vsrc+64+(long)(t)*KVBLK*DM,(unsigned)__builtin_amdgcn_readfirstlane(vdst+VOFF(t)+8192)); }while(0)
  typedef __attribute__((address_space(3))) char* lds_ptr; typedef __attribute__((address_space(3))) float* lds_fptr;
  const lds_ptr shm3=(lds_ptr)shm;
  const lds_fptr wsf=(lds_fptr)(shm3+LDS_WS+wid*256);
  const int NT=(q0+QB)/KVBLK;
  int sl_prev=0,sl_cur=0,sl_next=SLOTB;
  #define ROT() do{sl_prev=sl_cur;sl_cur=sl_next;sl_next=(sl_next==(NSLOT-1)*SLOTB)?0:sl_next+SLOTB;}while(0)
  #define ENDW(tt) do{ if((tt)+3<NT){WAIT_BAR(3);} else if((tt)+2<NT){WAIT_BAR(2);} else {WAIT_BAR(0);} }while(0)
  DMA_K(0,0);DMA_V(0);DMA_K(1,SLOTB);DMA_V(1);DMA_K(2,2*SLOTB);DMA_V(2);
  const bf16*Qw=Q+(rowbase+q0+wid*QBLK)*DM+h*D;
  bf16x8 qr[4];
  #pragma unroll
  for(int d0=0;d0<4;++d0)qr[d0]=*reinterpret_cast<const bf16x8*>(&Qw[(long)r32*DM+d0*16+hi*8]);
  float mhat=0.f,l_reg=0.f;f32x16 negm;f32x16 o[4];
  _Pragma("unroll") for(int r=0;r<16;++r){float z0,z1,z2,z3,z4; asm volatile("v_mov_b32 %0, 0\n\tv_mov_b32 %1, 0\n\tv_mov_b32 %2, 0\n\tv_mov_b32 %3, 0\n\tv_mov_b32 %4, 0":"=v"(z0),"=v"(z1),"=v"(z2),"=v"(z3),"=v"(z4)); o[0][r]=z0;o[1][r]=z1;o[2][r]=z2;o[3][r]=z3;negm[r]=z4;}
  const int qrel=wid*QBLK+r32;
  const lds_cptr kp0=(lds_cptr)shm3+LDS_K+hi*1024+r32*16;
  const int vb0=(int)(lds0+LDS_V)+((lane>>4)&1)*32+(lane&3)*8+(4*hi+((lane&15)>>2))*64;
  bf16x8 kf[8];
  #define MF(a,b,c) __builtin_amdgcn_mfma_f32_32x32x16_bf16(a,b,c,0,0,0)
  #define MX3(a,b,c) __builtin_fmaxf(__builtin_fmaxf((a),(b)),(c))
  u32x4 pw0,pw1,pw2,pw3;
  #define RD8(set,ks) do{ _Pragma("unroll") for(int d0=0;d0<4;++d0){ \
      asm volatile("ds_read_b64_tr_b16 %0,%1 offset:%c2":"=&v"(vlo_[set][d0]):"v"(vb_),"i"(d0*4096+(ks)*1024):"memory"); \
      asm volatile("ds_read_b64_tr_b16 %0,%1 offset:%c2":"=&v"(vhi_[set][d0]):"v"(vb_),"i"(d0*4096+(ks)*1024+512):"memory");} }while(0)
  #define PK(set,k) (bf16x8){vlo_[set][k][0],vlo_[set][k][1],vlo_[set][k][2],vlo_[set][k][3],vhi_[set][k][0],vhi_[set][k][1],vhi_[set][k][2],vhi_[set][k][3]}
  #define EX2(X,i) do{ X[i]=__builtin_amdgcn_exp2f(X[i]); X[(i)+1]=__builtin_amdgcn_exp2f(X[(i)+1]); sa_+=X[i]; sb_+=X[(i)+1]; asm volatile("":"+v"(sa_),"+v"(sb_)); }while(0)
  #define PVX(set,pw_,X,B) do{ const bf16x8 pa_=__builtin_bit_cast(bf16x8,pw_); \
      o[0]=MF(pa_,PK(set,0),o[0]); EX2(X,(B)+0); asm volatile("":"+v"(X)); SBAR(); \
      o[1]=MF(pa_,PK(set,1),o[1]); EX2(X,(B)+2); asm volatile("":"+v"(X)); SBAR(); \
      o[2]=MF(pa_,PK(set,2),o[2]); EX2(X,(B)+4); asm volatile("":"+v"(X)); SBAR(); \
      o[3]=MF(pa_,PK(set,3),o[3]); EX2(X,(B)+6); asm volatile("":"+v"(X)); SBAR(); }while(0)
  #define ASTEP(s,FIRST,GK,GV,GL,LATE) do{ \
    f32x16 c0=MF(kf[0],qr[0],negm),c1=MF(kf[1],qr[0],negm); c0=MF(kf[2],qr[1],c0);c1=MF(kf[3],qr[1],c1); c0=MF(kf[4],qr[2],c0);c1=MF(kf[5],qr[2],c1); c0=MF(kf[6],qr[3],c0);c1=MF(kf[7],qr[3],c1); \
    if(GK){DMA_K((s)+3,sl_cur);} if(GV){DMA_V((s)+2);} \
    if(GL){kload8(kf,kp0+sl_next);} \
    { const int jb_=(s)-(NT-4); if(jb_>=-2)cmask(c0,c1,jb_,qrel,hi,bt); } \
    float a_=MX3(c0[0],c0[1],c1[0]),b_=MX3(c0[2],c0[3],c1[1]); a_=MX3(a_,c1[2],c1[3]); \
    _Pragma("unroll") for(int r=4;r<16;r+=4){a_=MX3(a_,c0[r],c0[r+1]);b_=MX3(b_,c0[r+2],c0[r+3]);a_=MX3(a_,c1[r],c1[r+1]);b_=MX3(b_,c1[r+2],c1[r+3]);} \
    float rm=__builtin_fmaxf(a_,b_); { auto rr=__builtin_amdgcn_permlane32_swap(__float_as_uint(rm),__float_as_uint(rm),false,false); rm=__builtin_fmaxf(__uint_as_float(rr[0]),__uint_as_float(rr[1])); } \
    bool resc_=false; \
    if(FIRST){ const float dl=rm; mhat+=dl; _Pragma("unroll") for(int r=0;r<16;++r){c0[r]-=dl;c1[r]-=dl;} _Pragma("unroll") for(int r=0;r<16;++r)negm[r]=-mhat; asm volatile("":"+v"(negm)); } \
    else if(__builtin_expect(__any(rm>(float)THRL),0)){ const float dl=__builtin_fmaxf(rm,0.f); mhat+=dl; \
      _Pragma("unroll") for(int r=0;r<16;++r){c0[r]-=dl;c1[r]-=dl;} _Pragma("unroll") for(int r=0;r<16;++r)negm[r]=-mhat; asm volatile("":"+v"(negm)); \
      const float f=__builtin_amdgcn_exp2f(-dl); l_reg*=f; if(hi==0)wsf[r32]=f; resc_=true; } \
    float sa_=0.f,sb_=0.f; \
    if(FIRST){ _Pragma("unroll") for(int r=0;r<16;++r){c0[r]=__builtin_amdgcn_exp2f(c0[r]);c1[r]=__builtin_amdgcn_exp2f(c1[r]);sa_+=c0[r];sb_+=c1[r];} } \
    else { s16x4 vlo_[2][4],vhi_[2][4]; const int vb_=vb0+VOFF((s)-1); \
      SBAR(); \
      RD8(0,0); \
      RD8(1,1); asm volatile("s_waitcnt lgkmcnt(8)":::"memory"); SBAR(); PVX(0,pw0,c0,0); \
      RD8(0,2); asm volatile("s_waitcnt lgkmcnt(8)":::"memory"); SBAR(); PVX(1,pw1,c0,8); \
      RD8(1,3); asm volatile("s_waitcnt lgkmcnt(8)":::"memory"); SBAR(); PVX(0,pw2,c1,0); \
      asm volatile("s_waitcnt lgkmcnt(0)":::"memory"); SBAR(); PVX(1,pw3,c1,8); \
      if(resc_){ _Pragma("unroll") for(int r=0;r<16;++r){ const float f_=wsf[crow(r,hi)]; o[0][r]*=f_;o[1][r]*=f_;o[2][r]*=f_;o[3][r]*=f_; } } } \
    l_reg+=sa_+sb_; \
    pw0=(u32x4){cvtpk_s(c0[0],c0[1]),cvtpk_s(c0[2],c0[3]),cvtpk_s(c0[4],c0[5]),cvtpk_s(c0[6],c0[7])}; pw1=(u32x4){cvtpk_s(c0[8],c0[9]),cvtpk_s(c0[10],c0[11]),cvtpk_s(c0[12],c0[13]),cvtpk_s(c0[14],c0[15])}; \
    pw2=(u32x4){cvtpk_s(c1[0],c1[1]),cvtpk_s(c1[2],c1[3]),cvtpk_s(c1[4],c1[5]),cvtpk_s(c1[6],c1[7])}; pw3=(u32x4){cvtpk_s(c1[8],c1[9]),cvtpk_s(c1[10],c1[11]),cvtpk_s(c1[12],c1[13]),cvtpk_s(c1[14],c1[15])}; \
  }while(0)
  WAIT_BAR(3);
  kload8(kf,kp0);
  #define STEPS(LATE) do{ \
    ASTEP(0,true,false,false,true,LATE);                      \
    WAIT_BAR(0);                                              \
    DMA_K(3,0);                                               \
    ROT(); \
    int t=1; \
    for(;t+7<NT;t+=2){ \
      ASTEP(t,false,true,true,true,LATE);     WAIT_BAR(3); ROT(); \
      ASTEP(t+1,false,true,true,true,LATE);   WAIT_BAR(3); ROT(); \
    } \
    for(;t+1<NT;t+=2){ \
      ASTEP(t,false,(t+3<NT),(t+2<NT),(t+1<NT),LATE);       ENDW(t);   ROT(); \
      ASTEP(t+1,false,(t+4<NT),(t+3<NT),(t+2<NT),LATE);     ENDW(t+1); ROT(); \
    } \
    ASTEP(NT-1,false,false,false,false,LATE); \
    if(LATE){ pv4(o,vb0+VOFF(NT-1),__builtin_bit_cast(bf16x8,pw0),__builtin_bit_cast(bf16x8,pw1),__builtin_bit_cast(bf16x8,pw2),__builtin_bit_cast(bf16x8,pw3)); } \
  }while(0)
  if(wid>=4) __builtin_amdgcn_s_setprio(1);
  STEPS(true);
  __builtin_amdgcn_s_setprio(0);
  #undef STEPS
  #undef ASTEP
  #undef PVX
  #undef EX2
  #undef PK
  #undef RD8
  #undef MF
  #undef MX3
  {auto rr=__builtin_amdgcn_permlane32_swap(__float_as_uint(l_reg),__float_as_uint(l_reg),false,false);l_reg=__uint_as_float(rr[0])+__uint_as_float(rr[1]);}
  if(hi==0)wsf[32+r32]=l_reg;
  asm volatile("s_waitcnt vmcnt(0) lgkmcnt(0)\n\ts_barrier":::"memory");
  float rli[16];
  #pragma unroll
  for(int r=0;r<16;++r)rli[r]=__builtin_amdgcn_rcpf(wsf[32+crow(r,hi)]);
  bf16*Ow=O+(rowbase+q0+wid*QBLK)*ODM+h*128;
  { bf16*stg=(bf16*)(shm+wid*8192);
    #pragma unroll
    for(int r=0;r<16;++r){const int orow=crow(r,hi);
      #pragma unroll
      for(int d0=0;d0<4;++d0)stg[orow*128+d0*32+r32]=__float2bfloat16(o[d0][r]*rli[r]);}
    asm volatile("s_waitcnt lgkmcnt(0)":::"memory");
    #pragma unroll
    for(int i=0;i<8;++i){const int row=i*4+(lane>>4),ch=lane&15; const u32x4 v=*(const u32x4*)(stg+row*128+ch*8); ATTN_STORE16(Ow+(long)row*ODM+ch*8,v);} }
  asm volatile("s_waitcnt lgkmcnt(0)\n\ts_barrier":::"memory");
  #undef DMA_K
  #undef DMA_V
  #undef VOFF
  #undef ROT
  #undef ENDW
}
constexpr int ATTN_LDS_BYTES=LDS_BYTES;
#undef SBAR
#undef WAIT_BAR
}
#define LAS __attribute__((address_space(3)))
typedef unsigned short bf16;
typedef unsigned v4u __attribute__((ext_vector_type(4)));
typedef unsigned v2u __attribute__((ext_vector_type(2)));
typedef float f32x4 __attribute__((ext_vector_type(4)));
typedef short bf16x8 __attribute__((ext_vector_type(8)));
typedef float f32x16 __attribute__((ext_vector_type(16)));
#define LDS_WAIT() asm volatile("s_waitcnt lgkmcnt(0)" ::: "memory")
constexpr int NWAVES = 8, NTHR = 512;
constexpr int D = 2048, MROWS = 33792, MP = 32768, NIN = 5120, DFF = 5632;
constexpr float EPS = 1e-6f, LOG2E = 1.4426950408889634f;
constexpr size_t MiB = 1u << 20;
constexpr size_t WS_BAR = 983040, WS_MOD = 0, WS_MODF = 1 * MiB, WS_WIN = 2 * MiB, WS_WOUT = 22 * MiB, WS_WFI = 30 * MiB, WS_WFO = 74 * MiB, WS_H = 96 * MiB, WS_CAT = 228 * MiB,
                 WS_U = 360 * MiB, WS_G = 426 * MiB, WS_Q = 492 * MiB, WS_K = 558 * MiB, WS_V = 624 * MiB, WS_O = 690 * MiB, WS_F = 228 * MiB, WS_X1B = 690 * MiB, WS_X2B = 96 * MiB, WS_PART = 822 * MiB, WS_END = 854 * MiB;
constexpr long OUT_Y = 0, OUT_GVS = 138412032L;
constexpr int LDS_BYTES = 147456, RING_BYTES = 131072, BT_OFF = 126976;
static_assert(attn_body::ATTN_LDS_BYTES <= BT_OFF && BT_OFF + 8 * 196 * 4 <= LDS_BYTES, "LDS map");

__device__ __forceinline__ unsigned f2bf(float f) { unsigned u = __builtin_bit_cast(unsigned, f); return (u + 0x7fffu + ((u >> 16) & 1u)) >> 16; }
typedef float f32x2_pk __attribute__((ext_vector_type(2))); typedef __bf16 bf16x2_pk __attribute__((ext_vector_type(2)));
__device__ __forceinline__ unsigned pk2(float lo, float hi) { f32x2_pk v = {lo, hi}; bf16x2_pk b = __builtin_convertvector(v, bf16x2_pk); return __builtin_bit_cast(unsigned, b); }
__device__ __forceinline__ float bf2f(unsigned short h) { return __builtin_bit_cast(float, (unsigned)h << 16); }
__device__ __forceinline__ float bflo(unsigned w) { return __builtin_bit_cast(float, w << 16); }
__device__ __forceinline__ float bfhi(unsigned w) { return __builtin_bit_cast(float, w & 0xffff0000u); }
__device__ __forceinline__ float wave_sum(float v) {
#pragma unroll
    for (int o = 1; o < 64; o <<= 1) v += __shfl_xor(v, o);
    return v;
}
__device__ __forceinline__ int row_batch(int row) { return row < MP ? (row >> 14) : 2 + ((row - MP) >> 6); }

struct Args { const float* in[27]; float* out; unsigned char* ws; int ph_lo, ph_hi; };
enum { I_XP = 0, I_XS, I_CK, I_CV, I_CP, I_CS, I_RB, I_WADA, I_BADA, I_WADAF, I_BADAF, I_GMIX, I_GFFN, I_GFIN, I_WIN, I_LNG, I_LNB, I_WS, I_BS, I_LQ1, I_LK1, I_LQ2, I_LK2, I_SUBG, I_WOUT, I_WFI, I_WFO };

__device__ __forceinline__ void p0_transpose_item(const float* W, int K, int N, bf16* WT, int mode, LAS float* scr, int item, int lane) {
    const int nblk = N / 64, kb = item / nblk, nb = item % nblk, k0 = 64 * kb, n0 = 64 * nb;
    int rbase = n0;
    if (mode == 1) { const int j = n0 < DFF ? n0 : n0 - DFF; rbase = (j >> 7) * 256 + (n0 < DFF ? 0 : 128) + (j & 127); }
    const float* src = W + (size_t)k0 * N + n0 + lane;
    float wv[64];
#pragma unroll
    for (int i = 0; i < 64; ++i) wv[i] = src[(size_t)i * N];
#pragma unroll
    for (int i = 0; i < 64; ++i) scr[i * 65 + lane] = wv[i];
    LDS_WAIT(); asm volatile("" ::: "memory");
    const int c = lane & 7;
#pragma unroll
    for (int j = 0; j < 8; ++j) { const int n = (lane >> 3) + 8 * j; const LAS float* s = scr + (8 * c) * 65 + n;
        v4u o; o.x = pk2(s[0 * 65], s[1 * 65]); o.y = pk2(s[2 * 65], s[3 * 65]); o.z = pk2(s[4 * 65], s[5 * 65]); o.w = pk2(s[6 * 65], s[7 * 65]);
        *(v4u*)(WT + (size_t)(rbase + n) * K + k0 + 8 * c) = o; }
    LDS_WAIT(); asm volatile("" ::: "memory");
}
__device__ __forceinline__ void adaln_unit(const Args& a, LAS unsigned char* lds, int unit, int tid, int wave, int lane) {
    LAS float* sc = (LAS float*)lds;
    LAS float* red = (LAS float*)(lds + 18 * 1024 * 4);
    const int j0 = unit * 64; const bool fin = j0 >= 12288;
    const float* W = fin ? a.in[I_WADAF] : a.in[I_WADA]; const int N = fin ? 4096 : 12288; const int jc = (fin ? j0 - 12288 : j0) + lane;
    float acc[18];
#pragma unroll
    for (int r = 0; r < 18; ++r) acc[r] = 0.f;
    for (int kh = 0; kh < 2; ++kh) {
        __syncthreads();
        for (int i = tid; i < 18 * 1024; i += NTHR) { const int r = i >> 10, k = (i & 1023) + kh * 1024; const float c = r < 2 ? a.in[I_CP][r * 2048 + k] : a.in[I_CS][(r - 2) * 2048 + k];
            sc[i] = c / (1.0f + __expf(-c)); }
        __syncthreads();
        const int kb = wave * 128;
        for (int k = 0; k < 128; k += 16) {
            float w[16];
#pragma unroll
            for (int e = 0; e < 16; ++e) w[e] = W[(size_t)(kh * 1024 + kb + k + e) * N + jc];
#pragma unroll
            for (int q = 0; q < 4; ++q)
#pragma unroll
                for (int r = 0; r < 18; ++r) { const f32x4 s = *(const LAS f32x4*)(sc + r * 1024 + kb + k + 4 * q); acc[r] += s[0] * w[4 * q] + s[1] * w[4 * q + 1] + s[2] * w[4 * q + 2] + s[3] * w[4 * q + 3]; }
        }
    }
#pragma unroll
    for (int r = 0; r < 18; ++r) red[(wave * 18 + r) * 64 + lane] = acc[r];
    __syncthreads();
    for (int i = tid; i < 18 * 64; i += NTHR) { const int r = i >> 6, l = i & 63; float s = 0.f;
#pragma unroll
        for (int w = 0; w < 8; ++w) s += red[(w * 18 + r) * 64 + l];
        const int j = (fin ? j0 - 12288 : j0) + l;
        if (fin) ((float*)(a.ws + WS_MODF))[r * 4096 + j] = s + a.in[I_BADAF][j]; else ((float*)(a.ws + WS_MOD))[r * 12288 + j] = s + a.in[I_BADA][j]; }
    __syncthreads();
}
__device__ __forceinline__ void p0_prologue(const Args& a, LAS unsigned char* lds, int vcu, int G, int tid, int wave, int lane) {
    for (int rp = 0, nrp = opaque_i(((PROBE_REP >> 12) & 1) ? 2 : 1); rp < nrp; ++rp)
    for (int u = vcu; u < 256; u += G) adaln_unit(a, lds, u, tid, wave, lane);
    LAS float* scr = (LAS float*)(lds + wave * 17408);
    const int gw = vcu * NWAVES + wave, NGW = G * NWAVES;
    constexpr int I_1 = (D / 64) * (NIN / 64), I_2 = (D / 64) * (D / 64), I_3 = (D / 64) * (2 * DFF / 64), I_4 = (DFF / 64) * (D / 64);
    for (int it = gw; it < I_1 + I_2 + I_3 + I_4; it += NGW) {
        int r = it;
        if (r < I_1) { p0_transpose_item(a.in[I_WIN], D, NIN, (bf16*)(a.ws + WS_WIN), 0, scr, r, lane); continue; } r -= I_1;
        if (r < I_2) { p0_transpose_item(a.in[I_WOUT], D, D, (bf16*)(a.ws + WS_WOUT), 0, scr, r, lane); continue; } r -= I_2;
        if (r < I_3) { p0_transpose_item(a.in[I_WFI], D, 2 * DFF, (bf16*)(a.ws + WS_WFI), 1, scr, r, lane); continue; } r -= I_3;
        p0_transpose_item(a.in[I_WFO], DFF, D, (bf16*)(a.ws + WS_WFO), 0, scr, r, lane);
    }
}
template <bool F32OUT> __device__ __forceinline__ void norm_mod_rows(const float* fp, const float* fs, const bf16* bp, const bf16* bs, const float* g, const float* shift, const float* scale, int mstride, void* dst, int gw, int NGW, int lane, const float* part = nullptr, bf16* wb = nullptr) {
    for (int row = gw; row < MROWS; row += NGW) {
        const bool smp = row >= MP;
        const float* srcf = smp ? (fs ? fs + (size_t)(row - MP) * D : nullptr) : (fp ? fp + (size_t)row * D : nullptr);
        const bf16* srcb = (smp ? bs : bp) + (size_t)row * D;
        const int b = row_batch(row);
        f32x4 v[8]; float s = 0.f;
        if (srcf) {
#pragma unroll
            for (int j = 0; j < 8; ++j) v[j] = *(const f32x4*)(srcf + 4 * lane + 256 * j);
        } else {
#pragma unroll
            for (int j = 0; j < 8; ++j) { const v2u w = *(const v2u*)(srcb + 4 * lane + 256 * j); v[j] = (f32x4){bflo(w.x), bfhi(w.x), bflo(w.y), bfhi(w.y)}; }
        }
        if (part && smp) {
#pragma unroll
            for (int sp = 0; sp < 4; ++sp) { const float* pp = part + ((size_t)sp * (MROWS - MP) + (size_t)(row - MP)) * D + 4 * lane;
#pragma unroll
                for (int j = 0; j < 8; ++j) v[j] += *(const f32x4*)(pp + 256 * j); }
            if (wb) {
#pragma unroll
                for (int j = 0; j < 8; ++j) { v2u w; w.x = pk2(v[j][0], v[j][1]); w.y = pk2(v[j][2], v[j][3]); *(v2u*)(wb + (size_t)row * D + 4 * lane + 256 * j) = w; } }
        }
#pragma unroll
        for (int j = 0; j < 8; ++j) s += (v[j][0] * v[j][0] + v[j][1] * v[j][1]) + (v[j][2] * v[j][2] + v[j][3] * v[j][3]);
        const float rstd = 1.0f / sqrtf(wave_sum(s) * (1.0f / D) + EPS);
#pragma unroll
        for (int j = 0; j < 8; ++j) { const int col = 4 * lane + 256 * j;
            const f32x4 gg = *(const f32x4*)(g + col), sh = *(const f32x4*)(shift + (size_t)b * mstride + col), sc = *(const f32x4*)(scale + (size_t)b * mstride + col);
            const f32x4 o = (v[j] * rstd * gg) * (sc + 1.0f) + sh;
            if (F32OUT) *(f32x4*)((float*)dst + (size_t)row * D + col) = o;
            else { v2u w; w.x = pk2(o[0], o[1]); w.y = pk2(o[2], o[3]); *(v2u*)((bf16*)dst + (size_t)row * D + col) = w; } }
    }
}
__device__ __forceinline__ float diff_lambda(const Args& a, int lane) {
    const float s1 = wave_sum(a.in[I_LQ1][lane] * a.in[I_LK1][lane]), s2 = wave_sum(a.in[I_LQ2][lane] * a.in[I_LK2][lane]);
    return __expf(s1) - __expf(s2) + 0.2f;
}
__device__ __forceinline__ void bias_table(const Args& a, LAS float* bt, int tid) {
    for (int i = tid; i < 8 * 193; i += NTHR) { const int h = i / 193, idx = i % 193, rel = idx - 128, n = rel < 0 ? -rel : rel;
        int bk; if (n < 8) bk = n; else { const int q = (n * n) >> 6; bk = 8 + (31 - __clz(q)); if (bk > 15) bk = 15; }
        if (rel > 0) bk += 16;
        bt[h * 196 + idx] = (a.in[I_RB][bk * 8 + h] - a.in[I_RB][15 * 8 + h]) * LOG2E; }
}
__device__ __forceinline__ int crow(int r, int hi) { return (r & 3) + 8 * (r >> 2) + 4 * hi; }
__device__ __forceinline__ bf16x8 cvt8(f32x4 a, f32x4 b) { v4u w; w.x = pk2(a[0], a[1]); w.y = pk2(a[2], a[3]); w.z = pk2(b[0], b[1]); w.w = pk2(b[2], b[3]); return __builtin_bit_cast(bf16x8, w); }

constexpr int TSTR = 136;
__device__ __forceinline__ void unpack16(const v4u w0, const v4u w1, float* v) {
    v[0] = bflo(w0.x); v[1] = bfhi(w0.x); v[2] = bflo(w0.y); v[3] = bfhi(w0.y); v[4] = bflo(w0.z); v[5] = bfhi(w0.z); v[6] = bflo(w0.w); v[7] = bfhi(w0.w);
    v[8] = bflo(w1.x); v[9] = bfhi(w1.x); v[10] = bflo(w1.y); v[11] = bfhi(w1.y); v[12] = bflo(w1.z); v[13] = bfhi(w1.z); v[14] = bflo(w1.w); v[15] = bfhi(w1.w);
}
__device__ __forceinline__ void sgate_unit(const Args& a, LAS unsigned char* lds, int c, int tid, int wave, int lane) {
    asm volatile("" : "+v"(lane), "+v"(tid));
    const bool smp = c >= 256; const int T = smp ? 64 : 128; const int row0 = smp ? MP + 64 * (c - 256) : 128 * c;
    const bf16* Gb = (const bf16*)(a.ws + WS_G); const bf16* Ub = (const bf16*)(a.ws + WS_U); bf16* CAT = (bf16*)(a.ws + WS_CAT);
    LAS bf16* tile0 = (LAS bf16*)lds;
    LAS float* stats = (LAS float*)(lds + 65536);
    __syncthreads();
    for (int rb = 0; rb < 16; rb += 4) { const int rbase = wave * 16 + rb; if (rbase >= T) break;
        v4u w[4][2];
#pragma unroll
        for (int q = 0; q < 4; ++q) { const v4u* gp = (const v4u*)(Gb + (size_t)(row0 + rbase + q) * 1024 + lane * 16); w[q][0] = gp[0]; w[q][1] = gp[1]; }
        float s1[4], s2[4];
#pragma unroll
        for (int q = 0; q < 4; ++q) { float v[16]; unpack16(w[q][0], w[q][1], v); s1[q] = 0.f; s2[q] = 0.f;
#pragma unroll
            for (int e = 0; e < 16; ++e) { s1[q] += v[e]; s2[q] += v[e] * v[e]; } }
#pragma unroll
        for (int o = 1; o < 64; o <<= 1) {
#pragma unroll
            for (int q = 0; q < 4; ++q) { s1[q] += __shfl_xor(s1[q], o); s2[q] += __shfl_xor(s2[q], o); } }
#pragma unroll
        for (int q = 0; q < 4; ++q) { const float mean = s1[q] * (1.0f / 1024.0f); const float var = fmaxf(s2[q] * (1.0f / 1024.0f) - mean * mean, 0.f); const float rstd = 1.0f / sqrtf(var + EPS);
            if (lane == 0) { stats[(rbase + q) * 2] = mean; stats[(rbase + q) * 2 + 1] = rstd; } } }
    __syncthreads();
    const int hi = lane >> 5, r32 = lane & 31, iblk = wave & 3, cpair = wave >> 2;
    const bool act = iblk * 32 < T; const int nks = iblk < 2 ? 4 : 8;
    const int nch = T * 16 / NTHR;
    v4u gpre[4];
#define SG_ISSUE(g) do { _Pragma("unroll") for (int q = 0; q < 4; ++q) if (q < nch) { const int idx = tid + q * NTHR; gpre[q] = *(const v4u*)(Gb + (size_t)(row0 + (idx >> 4)) * 1024 + (g) * 128 + (idx & 15) * 8); } } while (0)
#define SG_COMMIT(g) do { LAS bf16* tl = tile0 + ((g) & 1) * 16384; _Pragma("unroll") for (int q = 0; q < 4; ++q) if (q < nch) { const int idx = tid + q * NTHR; const int row = idx >> 4, c8 = (idx & 15) * 8; const v4u w = gpre[q]; \
            const float mean = stats[row * 2], rstd = stats[row * 2 + 1]; \
            const float* lg = a.in[I_LNG] + (g) * 128 + c8; const float* lb = a.in[I_LNB] + (g) * 128 + c8; \
            const f32x4 g0 = *(const f32x4*)lg, g1 = *(const f32x4*)(lg + 4), b0 = *(const f32x4*)lb, b1 = *(const f32x4*)(lb + 4); \
            f32x4 x0 = {bflo(w.x), bfhi(w.x), bflo(w.y), bfhi(w.y)}, x1 = {bflo(w.z), bfhi(w.z), bflo(w.w), bfhi(w.w)}; \
            x0 = (x0 - mean) * rstd * g0 + b0; x1 = (x1 - mean) * rstd * g1 + b1; \
            if (smp) { float* o = a.out + OUT_GVS + (size_t)(row0 - MP + row) * 1024 + (g) * 128 + c8; *(f32x4*)o = x0; *(f32x4*)(o + 4) = x1; } \
            v4u o; o.x = pk2(x0[0], x0[1]); o.y = pk2(x0[2], x0[3]); o.z = pk2(x1[0], x1[1]); o.w = pk2(x1[2], x1[3]); \
            *(LAS v4u*)(tl + (c8 >> 5) * 4096 + row * 32 + (c8 & 31)) = o; } } while (0)
    SG_ISSUE(0); SG_COMMIT(0);
    __syncthreads();
    for (int g = 0; g < 8; ++g) {
        if (g < 7) SG_ISSUE(g + 1);
        if (act) {
            const LAS bf16* tile = tile0 + (g & 1) * 16384;
            const float* wrow = a.in[I_WS] + ((size_t)g * 128 + iblk * 32 + r32) * 128 + 4 * hi;
            f32x4 ar[8][2];
#pragma unroll
            for (int ks = 0; ks < 8; ++ks) if (ks < nks) { ar[ks][0] = *(const f32x4*)(wrow + ks * 16); ar[ks][1] = *(const f32x4*)(wrow + ks * 16 + 8); }
            unsigned uu[16];
#pragma unroll
            for (int r = 0; r < 16; ++r) { const int i = iblk * 32 + crow(r, hi); const size_t ro = (size_t)(row0 + i); const int col = g * 128 + cpair * 64 + r32;
                uu[r] = (unsigned)Ub[ro * 1024 + col] | ((unsigned)Ub[ro * 1024 + col + 32] << 16); }
            f32x16 acc0 = {}, acc1 = {};
#pragma unroll
            for (int ks = 0; ks < 8; ++ks) if (ks < nks) {
                const bf16x8 af = cvt8(ar[ks][0], ar[ks][1]);
                const attn_body::lds_cptr tp = (attn_body::lds_cptr)tile + (cpair * 2) * 8192 + ks * 1024 + ((lane >> 4) & 1) * 32 + (lane & 3) * 8 + (4 * hi + ((lane & 15) >> 2)) * 64;
                const attn_body::s16x4 l0 = attn_body::vtr(tp), h0 = attn_body::vtr(tp + 512), l1 = attn_body::vtr(tp + 8192), h1 = attn_body::vtr(tp + 8192 + 512);
                const bf16x8 b0 = {l0[0], l0[1], l0[2], l0[3], h0[0], h0[1], h0[2], h0[3]}, b1 = {l1[0], l1[1], l1[2], l1[3], h1[0], h1[1], h1[2], h1[3]};
                acc0 = __builtin_amdgcn_mfma_f32_32x32x16_bf16(af, b0, acc0, 0, 0, 0);
                acc1 = __builtin_amdgcn_mfma_f32_32x32x16_bf16(af, b1, acc1, 0, 0, 0);
            }
#pragma unroll
            for (int r = 0; r < 16; ++r) { const int i = iblk * 32 + crow(r, hi);
                const size_t ro = (size_t)(row0 + i); const int col = g * 128 + cpair * 64 + r32;
                const float bs = a.in[I_BS][g * 128 + i];
                CAT[ro * 2048 + col] = (bf16)f2bf(bflo(uu[r]) * (acc0[r] + bs)); CAT[ro * 2048 + col + 32] = (bf16)f2bf(bfhi(uu[r]) * (acc1[r] + bs)); }
        }
        if (g < 7) SG_COMMIT(g + 1);
        __syncthreads();
    }
#undef SG_ISSUE
#undef SG_COMMIT
}
__device__ __forceinline__ void sattn_unit(const Args& a, LAS unsigned char* lds, const LAS float* bt, int db, int h, int t, int tid, int wave, int lane) {
    asm volatile("" : "+v"(lane), "+v"(tid));
    const int qg = wave & 1, dvh = (wave >> 1) & 1, ksp = wave >> 2, hi = lane >> 5, r32 = lane & 31;
    const bf16* Qb = (const bf16*)(a.ws + WS_Q); const bf16* Kb = (const bf16*)(a.ws + WS_K); const bf16* Vb = (const bf16*)(a.ws + WS_V); bf16* Ob = (bf16*)(a.ws + WS_O);
    const float* CK = a.in[I_CK]; const float* CV = a.in[I_CV];
    const LAS float* bth = bt + h * 196;
    bf16x8 qr[4];
    { const bf16* qp = Qb + (size_t)(MP + db * 64 + qg * 32 + r32) * 1024 + h * 128 + t * 64 + hi * 8;
#pragma unroll
      for (int d0 = 0; d0 < 4; ++d0) qr[d0] = *(const bf16x8*)(qp + d0 * 16); }
    float m = -1e30f, l = 0.f; f32x16 o[2];
    o[0] = f32x16{}; o[1] = f32x16{};
    const unsigned klo = (unsigned)(r32 * 1024 + hi * 8), vlo = (unsigned)(hi * 4096 + dvh * 64 + r32), kco = (unsigned)((lane >> 4) * 1024 + (lane & 15) * 4);
    LAS float* kst = (LAS float*)(lds + 40960 + wave * 8704);
    f32x4 kr[8]; float vr[2][16];
#define SA_LOAD(K0) do { const float* kpu = CK + ((size_t)(db * 2048 + (K0)) * 8 + h) * 128 + t * 64; const float* vpu = CV + ((size_t)(db * 2048 + (K0)) * 8 + h) * 128; \
        _Pragma("unroll") for (int j = 0; j < 8; ++j) kr[j] = *(const f32x4*)(kpu + (kco + j * 4096)); \
        _Pragma("unroll") for (int e = 0; e < 8; ++e) { const float* r0 = vpu + crow(e, 0) * 1024; const float* r1 = vpu + (16 + crow(e, 0)) * 1024; \
            _Pragma("unroll") for (int d2 = 0; d2 < 2; ++d2) { vr[d2][e] = r0[vlo + d2 * 32]; vr[d2][8 + e] = r1[vlo + d2 * 32]; } } } while (0)
#define SA_CVT() do { _Pragma("unroll") for (int j = 0; j < 8; ++j) *(LAS f32x4*)(kst + ((lane >> 4) + 4 * j) * 68 + (lane & 15) * 4) = kr[j]; \
        _Pragma("unroll") for (int d0 = 0; d0 < 4; ++d0) { const LAS float* kp_ = kst + r32 * 68 + d0 * 16 + hi * 8; kf[d0] = cvt8(*(const LAS f32x4*)kp_, *(const LAS f32x4*)(kp_ + 4)); } \
        _Pragma("unroll") for (int d2 = 0; d2 < 2; ++d2) { \
            v4u w0, w1; w0.x = pk2(vr[d2][0], vr[d2][1]); w0.y = pk2(vr[d2][2], vr[d2][3]); w0.z = pk2(vr[d2][4], vr[d2][5]); w0.w = pk2(vr[d2][6], vr[d2][7]); \
            w1.x = pk2(vr[d2][8], vr[d2][9]); w1.y = pk2(vr[d2][10], vr[d2][11]); w1.z = pk2(vr[d2][12], vr[d2][13]); w1.w = pk2(vr[d2][14], vr[d2][15]); \
            vf[d2][0] = __builtin_bit_cast(bf16x8, w0); vf[d2][1] = __builtin_bit_cast(bf16x8, w1); } } while (0)
#define SA_COMPUTE(K0) do { f32x16 s = f32x16{}; \
        _Pragma("unroll") for (int d0 = 0; d0 < 4; ++d0) s = __builtin_amdgcn_mfma_f32_32x32x16_bf16(kf[d0], qr[d0], s, 0, 0, 0); \
        const int relb = (K0) - (2048 + qg * 32 + r32) + 128; float mx = -1e30f; \
        if ((K0) > 1926 + qg * 32) {     \
            _Pragma("unroll") for (int r = 0; r < 16; ++r) { int idx = relb + crow(r, hi); idx = idx < 0 ? 0 : (idx > 192 ? 192 : idx); s[r] += bth[idx]; } } \
        _Pragma("unroll") for (int r = 0; r < 16; ++r) mx = fmaxf(mx, s[r]); \
        mx = fmaxf(mx, __shfl_xor(mx, 32)); \
        const float mn = fmaxf(m, mx); \
        if (__any(mn > m)) { const float alpha = __builtin_amdgcn_exp2f(m - mn); l *= alpha; \
            _Pragma("unroll") for (int r = 0; r < 16; ++r) { const float ar = __shfl(alpha, crow(r, hi)); o[0][r] *= ar; o[1][r] *= ar; } } \
        m = mn; float rs = 0.f; \
        _Pragma("unroll") for (int r = 0; r < 16; ++r) { s[r] = __builtin_amdgcn_exp2f(s[r] - mn); rs += s[r]; } \
        l += rs; \
        v4u p0, p1; p0.x = pk2(s[0], s[1]); p0.y = pk2(s[2], s[3]); p0.z = pk2(s[4], s[5]); p0.w = pk2(s[6], s[7]); \
        p1.x = pk2(s[8], s[9]); p1.y = pk2(s[10], s[11]); p1.z = pk2(s[12], s[13]); p1.w = pk2(s[14], s[15]); \
        const bf16x8 pa0 = __builtin_bit_cast(bf16x8, p0), pa1 = __builtin_bit_cast(bf16x8, p1); \
        _Pragma("unroll") for (int d2 = 0; d2 < 2; ++d2) { \
            o[d2] = __builtin_amdgcn_mfma_f32_32x32x16_bf16(pa0, vf[d2][0], o[d2], 0, 0, 0); \
            o[d2] = __builtin_amdgcn_mfma_f32_32x32x16_bf16(pa1, vf[d2][1], o[d2], 0, 0, 0); } } while (0)
    const int tile0 = ksp * 33, nf = ksp ? 31 : 33;
    SA_LOAD(tile0 * 32);
    for (int it = 0; it < nf; ++it) {
        const int key0 = __builtin_amdgcn_readfirstlane((tile0 + it) * 32);
        bf16x8 kf[4]; bf16x8 vf[2][2];
        SA_CVT();
        if (it + 1 < nf) SA_LOAD(key0 + 32);
        SA_COMPUTE(key0);
    }
    if (ksp == 1) {
        for (int it = 0; it < 2; ++it) {
            const int key0 = 2048 + it * 32;
            bf16x8 kf[4]; bf16x8 vf[2][2];
            const bf16* kpu = Kb + (size_t)(MP + db * 64 + key0 - 2048) * 1024 + h * 128 + t * 64;
            const bf16* vpu = Vb + (size_t)(MP + db * 64 + key0 - 2048) * 1024 + h * 128;
#pragma unroll
            for (int d0 = 0; d0 < 4; ++d0) kf[d0] = *(const bf16x8*)(kpu + (klo + d0 * 16));
#pragma unroll
            for (int e = 0; e < 8; ++e) { const bf16* r0 = vpu + crow(e, 0) * 1024; const bf16* r1 = vpu + (16 + crow(e, 0)) * 1024;
#pragma unroll
                for (int d2 = 0; d2 < 2; ++d2) { vf[d2][0][e] = (short)r0[vlo + d2 * 32]; vf[d2][1][e] = (short)r1[vlo + d2 * 32]; } }
            SA_COMPUTE(key0);
        }
    }
#undef SA_LOAD
#undef SA_CVT
#undef SA_COMPUTE
    l += __shfl_xor(l, 32);
    LAS float* xo = (LAS float*)lds;
    LAS float* xm = (LAS float*)(lds + 4 * 2048 * 4);
    const int slot = wave & 3;
    __syncthreads();
    if (ksp == 1) {
#pragma unroll
        for (int i = 0; i < 2; ++i)
#pragma unroll
            for (int r = 0; r < 16; ++r) xo[(slot * 32 + i * 16 + r) * 64 + lane] = o[i][r];
        xm[(slot * 2 + 0) * 64 + lane] = m; xm[(slot * 2 + 1) * 64 + lane] = l; }
    __syncthreads();
    if (ksp == 0) {
        const float m1 = xm[(slot * 2 + 0) * 64 + lane], l1 = xm[(slot * 2 + 1) * 64 + lane];
        const float mn = fmaxf(m, m1), a0 = __builtin_amdgcn_exp2f(m - mn), a1 = __builtin_amdgcn_exp2f(m1 - mn);
        const float inv = 1.0f / (l * a0 + l1 * a1); const float f0 = a0 * inv, f1 = a1 * inv;
#pragma unroll
        for (int r = 0; r < 16; ++r) { const float g0 = __shfl(f0, crow(r, hi)), g1 = __shfl(f1, crow(r, hi));
            bf16* op = Ob + (size_t)(MP + db * 64 + qg * 32 + crow(r, hi)) * 2048 + h * 256 + t * 128 + dvh * 64 + r32;
#pragma unroll
            for (int i = 0; i < 2; ++i) op[i * 32] = (bf16)f2bf(o[i][r] * g0 + xo[(slot * 32 + i * 16 + r) * 64 + lane] * g1); } }
    __syncthreads();
}
__device__ __forceinline__ void combine_rows(const Args& a, float lam, int gw, int NGW, int lane) {
    const bf16* O = (const bf16*)(a.ws + WS_O); bf16* CAT = (bf16*)(a.ws + WS_CAT);
    const int h = lane >> 3, d0 = (lane & 7) * 16;
    float sg[16];
#pragma unroll
    for (int e = 0; e < 16; ++e) sg[e] = a.in[I_SUBG][d0 + e] * 0.8f;
    for (int row = gw; row < MROWS; row += NGW) {
        const v4u* p1 = (const v4u*)(O + (size_t)row * 2048 + h * 256 + d0); const v4u* p2 = (const v4u*)(O + (size_t)row * 2048 + h * 256 + 128 + d0);
        const v4u a0 = p1[0], a1 = p1[1], b0 = p2[0], b1 = p2[1];
        const unsigned aw[8] = {a0.x, a0.y, a0.z, a0.w, a1.x, a1.y, a1.z, a1.w}, bw[8] = {b0.x, b0.y, b0.z, b0.w, b1.x, b1.y, b1.z, b1.w};
        float d[16]; float q = 0.f;
#pragma unroll
        for (int e = 0; e < 8; ++e) { d[2 * e] = bflo(aw[e]) - lam * bflo(bw[e]); d[2 * e + 1] = bfhi(aw[e]) - lam * bfhi(bw[e]); q += d[2 * e] * d[2 * e] + d[2 * e + 1] * d[2 * e + 1]; }
        q += __shfl_xor(q, 1); q += __shfl_xor(q, 2); q += __shfl_xor(q, 4);
        const float rs = 1.0f / sqrtf(q * (1.0f / 128.0f) + EPS);
        v4u o0, o1;
        o0.x = pk2(d[0] * rs * sg[0], d[1] * rs * sg[1]); o0.y = pk2(d[2] * rs * sg[2], d[3] * rs * sg[3]); o0.z = pk2(d[4] * rs * sg[4], d[5] * rs * sg[5]); o0.w = pk2(d[6] * rs * sg[6], d[7] * rs * sg[7]);
        o1.x = pk2(d[8] * rs * sg[8], d[9] * rs * sg[9]); o1.y = pk2(d[10] * rs * sg[10], d[11] * rs * sg[11]); o1.z = pk2(d[12] * rs * sg[12], d[13] * rs * sg[13]); o1.w = pk2(d[14] * rs * sg[14], d[15] * rs * sg[15]);
        v4u* dst = (v4u*)(CAT + (size_t)row * 2048 + 1024 + h * 128 + d0); dst[0] = o0; dst[1] = o1;
    }
}

constexpr int NPH = 10;
__global__ void __launch_bounds__(NTHR, 2) fwd_megakernel(Args args) {
    extern __shared__ __attribute__((aligned(16))) unsigned char lds_raw[];
    LAS unsigned char* lds = (LAS unsigned char*)lds_raw;
    const int wave = __builtin_amdgcn_readfirstlane((int)threadIdx.x >> 6);
#define FRESH() const int lane = fresh_lane(); const int tid = wave * 64 + lane; (void)tid
    const int G = gridDim.x, bx = blockIdx.x; const int vcu = (G % 8 == 0) ? (bx % 8) * (G / 8) + bx / 8 : bx;
    const int gw = vcu * NWAVES + wave, NGW = G * NWAVES;
    cg::grid_group grid = cg::this_grid();
    const int lo = args.ph_lo, hi = args.ph_hi; int nbar = 0;
#ifndef PH_ONLY
#define PH_ONLY -1
#endif
#define IN(k) ((PH_ONLY < 0 || PH_ONLY == (k)) && lo <= (k) && (k) < hi)
#define REPS(k) _Pragma("nounroll") for (int rep_ = 0, nrep_ = opaque_i(((PROBE_REP >> (k)) & 1) ? 2 : 1); rep_ < nrep_; ++rep_)
#define SEAM(k) do { if (IN(k) && IN((k) + 1)) { if ((k) == 0) grid.sync(); else { ++nbar; \
        asm volatile("s_waitcnt vmcnt(0) lgkmcnt(0)" ::: "memory"); __syncthreads(); \
        if (wave == 0) { if (fresh_lane() == 0) { unsigned* ctr = (unsigned*)(args.ws + WS_BAR); \
            __builtin_amdgcn_fence(__ATOMIC_RELEASE, "agent"); asm volatile("s_waitcnt vmcnt(0)" ::: "memory"); \
            __hip_atomic_fetch_add(ctr, 1u, __ATOMIC_RELAXED, __HIP_MEMORY_SCOPE_AGENT); \
            const unsigned want = (unsigned)G * (unsigned)nbar; \
            while (__hip_atomic_load(ctr, __ATOMIC_RELAXED, __HIP_MEMORY_SCOPE_AGENT) < want) __builtin_amdgcn_s_sleep(2); \
            __builtin_amdgcn_fence(__ATOMIC_ACQUIRE, "agent"); asm volatile("s_waitcnt vmcnt(0)" ::: "memory"); } } \
        __syncthreads(); } } } while (0)
    unsigned char* ws = args.ws;
    const float* mod = (const float*)(ws + WS_MOD); const float* modf = (const float*)(ws + WS_MODF);
    bf16* Hb = (bf16*)(ws + WS_H);

    if (IN(0)) REPS(0) { FRESH(); p0_prologue(args, lds, vcu, G, tid, wave, lane); }
    SEAM(0);
    if (IN(1)) REPS(1) { FRESH(); norm_mod_rows<false>(args.in[I_XP], args.in[I_XS], nullptr, nullptr, args.in[I_GMIX], mod + 0, mod + 2048, 12288, Hb, gw, NGW, lane); }
    SEAM(1);
    if (IN(2)) {
        pg8::Gemm g{Hb, (const bf16*)(ws + WS_WIN), MROWS, NIN, D}; pg8::StaticOrder S; S.init(MROWS, NIN, D, G, bx, ((PROBE_REP >> 2) & 1) + 1);
        pg8::EpiIn E{(bf16*)(ws + WS_U), (bf16*)(ws + WS_G), (bf16*)(ws + WS_Q), (bf16*)(ws + WS_K), (bf16*)(ws + WS_V), args.out};
        pg8::gemm_phase<pg8::EpiIn, pg8::StaticOrder, true, true>(lds, g, S, E, wave);
    }
    SEAM(2);
    if (IN(3)) {
        LAS float* bt = (LAS float*)(lds + BT_OFF);
        __syncthreads();
        { FRESH(); bias_table(args, bt, tid); }
        __syncthreads();
        REPS(10) for (int v = vcu; v < 256; v += G) {
#ifndef NO_SMALL
            { FRESH(); sattn_unit(args, lds, bt, v >> 4, (v >> 1) & 7, v & 1, tid, wave, lane); }
            { FRESH(); sgate_unit(args, lds, v, tid, wave, lane); } if (v >= 240) { FRESH(); sgate_unit(args, lds, 256 + (v - 240), tid, wave, lane); }
#endif
        }
        __syncthreads();
        REPS(11) for (int v = vcu; v < 256; v += G) {
            const int combo = v >> 3, j = v & 7; const int b = combo >> 4, hh = combo & 15;
#pragma nounroll
            for (int i = 0; i < 8; ++i) { const int x = 8 * (i >> 1) + j; int qb = (i & 1) ? 63 - x : x; int b_ = b, hh_ = hh; asm volatile("" : "+s"(qb), "+s"(b_), "+s"(hh_));
#ifndef NO_ATTN
                attn_body::attn_unit<8>(b_, hh_, qb, (const attn_body::bf16*)(ws + WS_Q), (const attn_body::bf16*)(ws + WS_K), (const attn_body::bf16*)(ws + WS_V), (attn_body::bf16*)(ws + WS_O), (char*)lds_raw, (attn_body::lds_cfptr)(bt + (hh_ >> 1) * 196), wave);
#endif
            }
        }
    }
    SEAM(3);
    if (IN(4)) REPS(4) { FRESH(); const float lam = diff_lambda(args, lane); combine_rows(args, lam, gw, NGW, lane); }
    SEAM(4);
    if (IN(5)) {
        pg8::Gemm g{(const bf16*)(ws + WS_CAT), (const bf16*)(ws + WS_WOUT), MROWS, D, D}; pg8::StaticOrder S; S.init(MROWS, D, D, G, bx, 1, 4);
        pg8::EpiRes E{args.in[I_XP], nullptr, (bf16*)(ws + WS_X1B), mod + 4096, (float*)(ws + WS_PART)};
        pg8::gemm_phase<pg8::EpiRes, pg8::StaticOrder, true, true>(lds, g, S, E, wave);
    }
    SEAM(5);
    if (IN(6)) REPS(6) { FRESH(); norm_mod_rows<false>(nullptr, args.in[I_XS], (const bf16*)(ws + WS_X1B), nullptr, args.in[I_GFFN], mod + 6144, mod + 8192, 12288, Hb, gw, NGW, lane, (const float*)(ws + WS_PART), (bf16*)(ws + WS_X1B)); }
    SEAM(6);
    if (IN(7)) {
        pg8::Gemm g{Hb, (const bf16*)(ws + WS_WFI), MROWS, 2 * DFF, D}; pg8::StaticOrder S; S.init(MROWS, 2 * DFF, D, G, bx, ((PROBE_REP >> 7) & 1) + 1);
        pg8::EpiGlu E{(bf16*)(ws + WS_F)};
        pg8::gemm_phase<pg8::EpiGlu, pg8::StaticOrder, true, true>(lds, g, S, E, wave);
    }
    SEAM(7);
    if (IN(8)) {
        pg8::Gemm g{(const bf16*)(ws + WS_F), (const bf16*)(ws + WS_WFO), MROWS, D, DFF}; pg8::StaticOrder S; S.init(MROWS, D, DFF, G, bx, 1, 4);
        pg8::EpiRes E{nullptr, (const bf16*)(ws + WS_X1B), (bf16*)(ws + WS_X2B), mod + 10240, (float*)(ws + WS_PART)};
        pg8::gemm_phase<pg8::EpiRes, pg8::StaticOrder, true, true>(lds, g, S, E, wave);
    }
    SEAM(8);
    if (IN(9)) { FRESH(); norm_mod_rows<true>(nullptr, nullptr, (const bf16*)(ws + WS_X2B), (const bf16*)(ws + WS_X1B), args.in[I_GFIN], modf + 0, modf + 2048, 4096, args.out + OUT_Y, gw, NGW, lane, (const float*)(ws + WS_PART), nullptr); }
#undef IN
#undef SEAM
}

#ifndef MK_ONE_LAUNCH
#define MK_ONE_LAUNCH 1
#endif
extern "C" void kernel_launch(void* const* d_in, const int* in_sizes, int n_in, void* d_out, int out_size, void* d_ws, size_t ws_size, hipStream_t stream) {
    static int grid = 0;
    if (grid == 0) {
        if (n_in != 27 || ws_size < WS_END) { fprintf(stderr, "kernel_launch: unexpected inputs (n_in %d, ws %zu)\n", n_in, ws_size); grid = -1; return; }
        int dev = 0, cus = 0, per_cu = 0;
        hipGetDevice(&dev); hipDeviceGetAttribute(&cus, hipDeviceAttributeMultiprocessorCount, dev);
        if (hipFuncSetAttribute((const void*)fwd_megakernel, hipFuncAttributeMaxDynamicSharedMemorySize, LDS_BYTES) != hipSuccess) { fprintf(stderr, "kernel_launch: hipFuncSetAttribute failed\n"); grid = -1; return; }
        if (hipOccupancyMaxActiveBlocksPerMultiprocessor(&per_cu, (const void*)fwd_megakernel, NTHR, LDS_BYTES) != hipSuccess || per_cu < 1) per_cu = 1;
        (void)hipGetLastError();
        grid = cus * per_cu; if (grid <= 0) grid = 256;
    }
    if (grid < 0) return;
    Args a{};
    for (int i = 0; i < 27; ++i) a.in[i] = (const float*)d_in[i];
    a.out = (float*)d_out; a.ws = (unsigned char*)d_ws;
#if MK_ONE_LAUNCH
    a.ph_lo = 0; a.ph_hi = NPH;
    (void)hipMemsetAsync((unsigned char*)d_ws + WS_BAR, 0, 256, stream);
    void* kargs[] = {&a};
    hipError_t e = hipLaunchCooperativeKernel((const void*)fwd_megakernel, dim3(grid), dim3(NTHR), kargs, LDS_BYTES, stream);
    if (e != hipSuccess) fprintf(stderr, "cooperative launch failed: %s (grid %d)\n", hipGetErrorString(e), grid);
#else
    for (int p = 0; p < NPH; ++p) { a.ph_lo = p; a.ph_hi = p + 1; hipLaunchKernelGGL(fwd_megakernel, dim3(grid), dim3(NTHR), LDS_BYTES, stream, a); }
#endif
}
```

```cpp
#include <hip/hip_runtime.h>
#include <hip/hip_bf16.h>
#include <hip/hip_cooperative_groups.h>
#include <cstdio>
#include <cstdint>
#include <cmath>
namespace cg = cooperative_groups;
#ifndef PROBE_REP
#define PROBE_REP 0
#endif
__device__ __forceinline__ int opaque_i(int v) { asm volatile("" : "+s"(v)); return v; }
__device__ __forceinline__ int fresh_lane() { int l; asm volatile("v_mbcnt_lo_u32_b32 %0, -1, 0\n\tv_mbcnt_hi_u32_b32 %0, -1, %0" : "=v"(l)); return l; }
namespace pg8 {
#define PG8_LAS __attribute__((address_space(3)))
typedef unsigned short bf16_t;
typedef short bf16x8 __attribute__((ext_vector_type(8)));
typedef float f32x4 __attribute__((ext_vector_type(4)));
typedef unsigned u32x4 __attribute__((ext_vector_type(4)));
constexpr int BM = 256, BK = 64, HALF = 128, HTB = HALF * BK * 2  , STAGE_BYTES = 8 * HTB, NXCD = 8, WGM = 8;

__host__ __device__ __forceinline__ int lds_byte(int r, int c) { const int st = (r >> 4) * 2 + (c >> 5), rr = r & 15, cc = c & 31, ob = rr * 64 + cc * 2; return st * 1024 + (ob ^ (((ob >> 9) & 1) << 5)); }
__host__ __device__ __forceinline__ void stage_rc(int b, int& R, int& C) { const int st = b / 1024, sb = b % 1024, swz = sb ^ (((sb >> 9) & 1) << 5); R = (st >> 1) * 16 + swz / 64; C = (st & 1) * 32 + (swz % 64) / 2; }
__host__ __device__ __forceinline__ int perm32(int rho) { const int n = rho >> 4, i = rho & 15; return 8 * (i >> 2) + 4 * n + (i & 3); }

struct Unit { int pm, pn, k0, nt, split; };
struct Gemm { const bf16_t* A; const bf16_t* Bt; int M, N, K; };

struct StaticOrder {
    int nM, nN, nwg, G, c, rep, ntk, nsplit, nMmain;
    __host__ __device__ void init(int M, int N, int K, int G_, int c_, int rep_ = 1, int nsplit_ = 0) { nM = M / BM; nN = N / BM; G = G_; c = c_; rep = rep_; ntk = K / BK; nsplit = nsplit_;
        nMmain = nsplit_ > 0 ? 128 : nM; nwg = nMmain * nN; }
    __host__ __device__ bool next(int i, Unit& u) const {
        const long L = (long)i * G + c; u.k0 = 0; u.nt = ntk; u.split = 0;
        if (nsplit > 0 && L >= nwg) { const int s = (int)(L - nwg); if (s >= (nM - nMmain) * nN * nsplit) return false;
            const int tile = s / nsplit, ks = s % nsplit; u.pm = nMmain + tile / nN; u.pn = tile % nN; u.nt = ntk / nsplit; u.k0 = ks * u.nt; u.split = 1; return true; }
        if (L >= (long)nwg * rep) return false;
        int wgid = (int)(L % nwg); { const int q = nwg / NXCD, r = nwg % NXCD, xcd = wgid % NXCD, off = wgid / NXCD; wgid = (xcd < r ? xcd * (q + 1) : r * (q + 1) + (xcd - r) * q) + off; }
        const int nig = WGM * nN, gid = wgid / nig, fm = gid * WGM, gsz = (nMmain - fm) < WGM ? (nMmain - fm) : WGM;
        u.pm = fm + ((wgid % nig) % gsz); u.pn = (wgid % nig) / gsz; return true;
    }
    __device__ __forceinline__ void a_ready(const Unit&) const {}
    __device__ __forceinline__ void done(const Unit&) const {}
};

__device__ __forceinline__ unsigned cvt_pk_bf16(float lo, float hi) { unsigned r; asm volatile("v_cvt_pk_bf16_f32 %0, %1, %2" : "=v"(r) : "v"(lo), "v"(hi)); return r; }
typedef float f32x2 __attribute__((ext_vector_type(2)));
constexpr int MROWS = 33792, MP = 32768;
constexpr long OUT_Y = 0, OUT_KP = 69206016L, OUT_VP = 102760448L, OUT_KS = 136314880L, OUT_VS = 137363456L, OUT_GVS = 138412032L;
__device__ __forceinline__ int row_batch(int row) { return row < MP ? (row >> 14) : 2 + ((row - MP) >> 6); }
__device__ __forceinline__ float gelu_tanh(float x) { const float u = 0.7978845608028654f * (x + 0.044715f * x * x * x); const float e = __builtin_amdgcn_exp2f(-2.8853900817779268f * u); return x * __builtin_amdgcn_rcpf(1.0f + e); }
__device__ __forceinline__ float silu_f(float x) { const float e = __builtin_amdgcn_exp2f(-1.4426950408889634f * x); return x * __builtin_amdgcn_rcpf(1.0f + e); }
__device__ __forceinline__ u32x4 pack8(f32x4 v0, f32x4 v1) { u32x4 w; w.x = cvt_pk_bf16(v0[0], v0[1]); w.y = cvt_pk_bf16(v0[2], v0[3]); w.z = cvt_pk_bf16(v1[0], v1[1]); w.w = cvt_pk_bf16(v1[2], v1[3]); return w; }

struct EpiIn {
    static constexpr bool PERM = true, AFTER_DRAIN = false;
    bf16_t *U, *G, *Q, *Kb, *Vb; float* out;
    __device__ __forceinline__ void operator()(const f32x4 (&acc)[2][2][4][2], const Unit& u, int wr, int wc, int fr, int fq) const {
        const int seg = u.pn >> 2, colt = (u.pn & 3) * BM;
        const int row0 = u.pm * BM + wr * 64 + fr, col0 = colt + wc * 32 + 8 * fq;
        bf16_t* dst = seg == 0 ? U : seg == 1 ? G : seg == 2 ? Q : seg == 3 ? Kb : Vb;
#pragma unroll
        for (int ai = 0; ai < 2; ++ai)
#pragma unroll
            for (int m = 0; m < 4; ++m) { const int row = row0 + ai * HALF + m * 16;
#pragma unroll
                for (int bj = 0; bj < 2; ++bj) { f32x4 v0 = acc[ai][bj][m][0], v1 = acc[ai][bj][m][1]; const int col = col0 + bj * HALF;
                    if (seg < 2) {
#pragma unroll
                        for (int e = 0; e < 4; ++e) { v0[e] = gelu_tanh(v0[e]); v1[e] = gelu_tanh(v1[e]); }
                    } else if (seg == 2) { v0 = v0 * 0.18033688011112042f; v1 = v1 * 0.18033688011112042f; }
                    else { float* o = (row < MP) ? out + (seg == 3 ? OUT_KP : OUT_VP) + (size_t)row * 1024 + col : out + (seg == 3 ? OUT_KS : OUT_VS) + (size_t)(row - MP) * 1024 + col;
                        *(f32x4*)o = v0; *(f32x4*)(o + 4) = v1; }
                    *(u32x4*)(dst + (size_t)row * 1024 + col) = pack8(v0, v1); } }
    }
};
struct EpiRes {
    static constexpr bool PERM = true, AFTER_DRAIN = false;
    const float* xp; const bf16_t* baseb; bf16_t* outb; const float* gate; float* part;
    __device__ __forceinline__ void operator()(const f32x4 (&acc)[2][2][4][2], const Unit& u, int wr, int wc, int fr, int fq) const {
        const int row0 = u.pm * BM + wr * 64 + fr, col0 = u.pn * BM + wc * 32 + 8 * fq;
#pragma unroll
        for (int ai = 0; ai < 2; ++ai) {
            const int b = row_batch(u.pm * BM + ai * HALF + wr * 64);
            const float* gt = gate + (size_t)b * 12288 + col0;
            f32x4 g[2][2];
#pragma unroll
            for (int bj = 0; bj < 2; ++bj) { g[bj][0] = *(const f32x4*)(gt + bj * HALF); g[bj][1] = *(const f32x4*)(gt + bj * HALF + 4); }
#pragma unroll
            for (int m = 0; m < 4; ++m) { const int row = row0 + ai * HALF + m * 16;
#pragma unroll
                for (int bj = 0; bj < 2; ++bj) { const int col = col0 + bj * HALF;
                    if (u.split) { float* pp = part + ((size_t)(u.k0 / u.nt) * (MROWS - MP) + (size_t)(row - MP)) * 2048 + col;
                        *(f32x4*)pp = g[bj][0] * acc[ai][bj][m][0]; *(f32x4*)(pp + 4) = g[bj][1] * acc[ai][bj][m][1];
                    } else {
                        f32x4 b0, b1;
                        if (xp) { const float* src = xp + (size_t)row * 2048 + col; b0 = *(const f32x4*)src; b1 = *(const f32x4*)(src + 4); }
                        else { const u32x4 w = *(const u32x4*)(baseb + (size_t)row * 2048 + col);
                            b0 = (f32x4){__builtin_bit_cast(float, w.x << 16), __builtin_bit_cast(float, w.x & 0xffff0000u), __builtin_bit_cast(float, w.y << 16), __builtin_bit_cast(float, w.y & 0xffff0000u)};
                            b1 = (f32x4){__builtin_bit_cast(float, w.z << 16), __builtin_bit_cast(float, w.z & 0xffff0000u), __builtin_bit_cast(float, w.w << 16), __builtin_bit_cast(float, w.w & 0xffff0000u)}; }
                        *(u32x4*)(outb + (size_t)row * 2048 + col) = pack8(b0 + g[bj][0] * acc[ai][bj][m][0], b1 + g[bj][1] * acc[ai][bj][m][1]); } } }
        }
    }
};
struct EpiGlu {
    static constexpr bool PERM = true, AFTER_DRAIN = false;
    bf16_t* F;
    __device__ __forceinline__ void operator()(const f32x4 (&acc)[2][2][4][2], const Unit& u, int wr, int wc, int fr, int fq) const {
        const int row0 = u.pm * BM + wr * 64 + fr, col0 = u.pn * HALF + wc * 32 + 8 * fq;
#pragma unroll
        for (int ai = 0; ai < 2; ++ai)
#pragma unroll
            for (int m = 0; m < 4; ++m) { const int row = row0 + ai * HALF + m * 16;
                f32x4 v0, v1;
#pragma unroll
                for (int e = 0; e < 4; ++e) { v0[e] = silu_f(acc[ai][0][m][0][e]) * acc[ai][1][m][0][e]; v1[e] = silu_f(acc[ai][0][m][1][e]) * acc[ai][1][m][1][e]; }
                *(u32x4*)(F + (size_t)row * 5632 + col0) = pack8(v0, v1); }
    }
};

template <class Epi, class Sched, bool ALIGN_EPI = false, bool SP2 = false>
__device__ __forceinline__ void gemm_phase(PG8_LAS unsigned char* lds, const Gemm g, const Sched& S, const Epi& E, const int wid_in) {
    const int wid = wid_in, lane = fresh_lane(), tid = wid * 64 + lane, wr = wid >> 2, wc = wid & 3, fr = lane & 15, fq = lane >> 4;
    const int K = g.K;
    unsigned voffA[2], voffB[2];
#pragma unroll
    for (int i = 0; i < 2; ++i) { int R, C; stage_rc(tid * 16 + i * 8192, R, C); const int Rb = Epi::PERM ? ((R & ~31) + perm32(R & 31)) : R;
        voffA[i] = (unsigned)(R * K + C) * 2u; voffB[i] = (unsigned)(Rb * K + C) * 2u; }
    const size_t kstep = (size_t)(BK * 2);
    const size_t hstep = (size_t)HALF * K * 2;
    const size_t tstep = 2 * hstep;
    const unsigned ldsw = (unsigned)wid * 1024u;
    const int aoff = lds_byte(wr * 64 + fr, fq * 8), boff = lds_byte(wc * 32 + fr, fq * 8);
#define PG8_SA(b, h) (((b) * 2 + (h)) * HTB)
#define PG8_SB(b, h) ((4 + (b) * 2 + (h)) * HTB)
#define PG8_STAGE(bufoff, gbase, voff) do { _Pragma("unroll") for (int _i = 0; _i < 2; ++_i) \
        __builtin_amdgcn_global_load_lds((const unsigned*)((const char*)(gbase) + (voff)[_i]), (PG8_LAS unsigned*)(lds + (bufoff) + ldsw + _i * 8192), 16, 0, 0); } while (0)
#define PG8_LDA(dst, b, h) do { _Pragma("unroll") for (int m = 0; m < 4; ++m) _Pragma("unroll") for (int k = 0; k < 2; ++k) dst[m][k] = *(const PG8_LAS bf16x8*)(lds + PG8_SA(b, h) + aoff + m * 2048 + k * 1024); } while (0)
#define PG8_LDB(dst, b, h) do { _Pragma("unroll") for (int n = 0; n < 2; ++n) _Pragma("unroll") for (int k = 0; k < 2; ++k) dst[n][k] = *(const PG8_LAS bf16x8*)(lds + PG8_SB(b, h) + boff + n * 2048 + k * 1024); } while (0)
#define PG8_MMA(ai, bj, At, Bt) do { __builtin_amdgcn_s_setprio(1); _Pragma("unroll") for (int m = 0; m < 4; ++m) _Pragma("unroll") for (int n = 0; n < 2; ++n) _Pragma("unroll") for (int k = 0; k < 2; ++k) \
        acc[ai][bj][m][n] = __builtin_amdgcn_mfma_f32_16x16x32_bf16(Bt[n][k], At[m][k], acc[ai][bj][m][n], 0, 0, 0); __builtin_amdgcn_s_setprio(0); } while (0)
#define PG8_WAIT_V(n) asm volatile("s_waitcnt vmcnt(" #n ")" ::: "memory")
#define PG8_WAIT_L(n) asm volatile("s_waitcnt lgkmcnt(" #n ")" ::: "memory")
#define PG8_BAR __builtin_amdgcn_s_barrier()
#define PG8_SCHED __builtin_amdgcn_sched_barrier(0)
    Unit cur, nxt; int ui = 0;
    if (!S.next(0, cur)) return;
    f32x4 acc[2][2][4][2];
#pragma unroll
    for (int a = 0; a < 2; ++a)
#pragma unroll
        for (int b = 0; b < 2; ++b)
#pragma unroll
            for (int m = 0; m < 4; ++m)
#pragma unroll
                for (int n = 0; n < 2; ++n) acc[a][b][m][n] = (f32x4){0.f, 0.f, 0.f, 0.f};
    bf16x8 At[4][2], B0[2][2], B1[2][2];
    const char* cA = (const char*)g.A + (size_t)cur.pm * tstep + (size_t)cur.k0 * kstep; const char* cB = (const char*)g.Bt + (size_t)cur.pn * tstep + (size_t)cur.k0 * kstep;
    int nt = cur.nt;
    S.a_ready(cur);
    if constexpr (SP2) {
        PG8_STAGE(PG8_SB(0, 0), cB, voffB); PG8_STAGE(PG8_SB(0, 1), cB + hstep, voffB); PG8_STAGE(PG8_SA(0, 0), cA, voffA); PG8_STAGE(PG8_SA(0, 1), cA + hstep, voffA);
        if (wr == 1) PG8_BAR;
        PG8_WAIT_V(2); PG8_BAR;
        PG8_STAGE(PG8_SB(1, 0), cB + kstep, voffB); PG8_STAGE(PG8_SA(1, 0), cA + kstep, voffA); PG8_STAGE(PG8_SB(1, 1), cB + hstep + kstep, voffB);
        PG8_WAIT_V(6); PG8_BAR;
    } else {
        PG8_STAGE(PG8_SB(0, 0), cB, voffB); PG8_STAGE(PG8_SA(0, 0), cA, voffA); PG8_STAGE(PG8_SB(0, 1), cB + hstep, voffB); PG8_STAGE(PG8_SA(0, 1), cA + hstep, voffA);
        if (wr == 1) PG8_BAR;
        PG8_WAIT_V(4); PG8_BAR;
        PG8_STAGE(PG8_SB(1, 0), cB + kstep, voffB); PG8_STAGE(PG8_SA(1, 0), cA + kstep, voffA); PG8_STAGE(PG8_SB(1, 1), cB + hstep + kstep, voffB);
        PG8_WAIT_V(6); PG8_BAR;
    }
    for (;;) {
        const bool has_next = S.next(ui + 1, nxt);
        const char* nA = has_next ? (const char*)g.A + (size_t)nxt.pm * tstep + (size_t)nxt.k0 * kstep : cA; const char* nB = has_next ? (const char*)g.Bt + (size_t)nxt.pn * tstep + (size_t)nxt.k0 * kstep : cB;
        for (int t = 0; t < nt; t += 2) {
            const bool last = (t == nt - 2);
            const char* a1 = cA + (size_t)(t + 1) * kstep;
            const char* a2 = last ? nA : cA + (size_t)(t + 2) * kstep; const char* b2 = last ? nB : cB + (size_t)(t + 2) * kstep;
            const char* a3 = a2 + kstep; const char* b3 = b2 + kstep;
            if (last && has_next) S.a_ready(nxt);
            if constexpr (SP2) {
            PG8_LDB(B0, 0, 0); PG8_LDB(B1, 0, 1); PG8_SCHED; PG8_LDA(At, 0, 0); PG8_STAGE(PG8_SA(1, 1), a1 + hstep, voffA);
            PG8_WAIT_V(8); PG8_WAIT_L(0); PG8_BAR; PG8_MMA(0, 0, At, B0); PG8_MMA(0, 1, At, B1); PG8_BAR; PG8_SCHED;
            PG8_LDA(At, 0, 1); PG8_STAGE(PG8_SB(0, 0), b2, voffB); PG8_STAGE(PG8_SB(0, 1), b2 + hstep, voffB); PG8_STAGE(PG8_SA(0, 0), a2, voffA);
            PG8_WAIT_V(8); PG8_WAIT_L(0); PG8_BAR; PG8_MMA(1, 0, At, B0); PG8_MMA(1, 1, At, B1); PG8_BAR; PG8_SCHED;
            PG8_LDB(B0, 1, 0); PG8_LDB(B1, 1, 1); PG8_SCHED; PG8_LDA(At, 1, 0); PG8_STAGE(PG8_SA(0, 1), a2 + hstep, voffA);
            PG8_WAIT_V(8); PG8_WAIT_L(0); PG8_BAR; PG8_MMA(0, 0, At, B0); PG8_MMA(0, 1, At, B1); PG8_BAR; PG8_SCHED;
            PG8_LDA(At, 1, 1); PG8_STAGE(PG8_SB(1, 0), b3, voffB); PG8_STAGE(PG8_SB(1, 1), b3 + hstep, voffB); PG8_STAGE(PG8_SA(1, 0), a3, voffA);
            PG8_WAIT_V(8); PG8_WAIT_L(0); PG8_BAR; PG8_MMA(1, 0, At, B0); PG8_MMA(1, 1, At, B1); PG8_BAR; PG8_SCHED;
            } else {
            PG8_LDB(B0, 0, 0); PG8_SCHED; PG8_LDA(At, 0, 0); PG8_STAGE(PG8_SA(1, 1), a1 + hstep, voffA);
            PG8_WAIT_L(8); PG8_BAR; PG8_WAIT_L(0); PG8_MMA(0, 0, At, B0); PG8_BAR; PG8_SCHED;
            PG8_LDB(B1, 0, 1); PG8_STAGE(PG8_SB(0, 0), b2, voffB);
            PG8_BAR; PG8_WAIT_L(0); PG8_MMA(0, 1, At, B1); PG8_BAR;
            PG8_LDA(At, 0, 1); PG8_STAGE(PG8_SA(0, 0), a2, voffA);
            PG8_BAR; PG8_WAIT_L(0); PG8_MMA(1, 0, At, B0); PG8_BAR; PG8_SCHED;
            PG8_STAGE(PG8_SB(0, 1), b2 + hstep, voffB);
            PG8_WAIT_V(6); PG8_BAR; PG8_MMA(1, 1, At, B1); PG8_BAR;
            PG8_LDB(B0, 1, 0); PG8_SCHED; PG8_LDA(At, 1, 0); PG8_STAGE(PG8_SA(0, 1), a2 + hstep, voffA);
            PG8_WAIT_L(8); PG8_BAR; PG8_WAIT_L(0); PG8_MMA(0, 0, At, B0); PG8_BAR; PG8_SCHED;
            PG8_LDB(B1, 1, 1); PG8_STAGE(PG8_SB(1, 0), b3, voffB);
            PG8_BAR; PG8_WAIT_L(0); PG8_MMA(0, 1, At, B1); PG8_BAR;
            PG8_LDA(At, 1, 1); PG8_STAGE(PG8_SA(1, 0), a3, voffA);
            PG8_BAR; PG8_WAIT_L(0); PG8_MMA(1, 0, At, B0); PG8_BAR; PG8_SCHED;
            PG8_STAGE(PG8_SB(1, 1), b3 + hstep, voffB);
            PG8_WAIT_V(6); PG8_BAR; PG8_MMA(1, 1, At, B1); PG8_BAR;
            }
        }
        if constexpr (ALIGN_EPI) { if (wr == 0) PG8_BAR; }
        if constexpr (!Epi::AFTER_DRAIN) { E(acc, cur, wr, wc, fr, fq); S.done(cur); }
        if (!has_next) break;
#pragma unroll
        for (int a = 0; a < 2; ++a)
#pragma unroll
            for (int b = 0; b < 2; ++b)
#pragma unroll
                for (int m = 0; m < 4; ++m)
#pragma unroll
                    for (int n = 0; n < 2; ++n) acc[a][b][m][n] = (f32x4){0.f, 0.f, 0.f, 0.f};
        cur = nxt; cA = nA; cB = nB; ++ui; nt = cur.nt;
        if constexpr (ALIGN_EPI) { if (wr == 1) PG8_BAR; }
    }
    PG8_WAIT_V(0);
    if constexpr (!ALIGN_EPI) { if (wr == 0) PG8_BAR; }
    PG8_BAR;
    if constexpr (Epi::AFTER_DRAIN) { E.fused(acc, cur, wr, wc, fr, fq, lds, wid, lane); S.done(cur); }
#undef PG8_SA
#undef PG8_SB
#undef PG8_STAGE
#undef PG8_LDA
#undef PG8_LDB
#undef PG8_MMA
#undef PG8_WAIT_V
#undef PG8_WAIT_L
#undef PG8_BAR
#undef PG8_SCHED
}
}
namespace attn_body {
using bf16=__hip_bfloat16;
using bf16x8=__attribute__((ext_vector_type(8)))short;
using s16x4=__attribute__((ext_vector_type(4)))short;
using f32x16=__attribute__((ext_vector_type(16)))float;
using u32x4=__attribute__((ext_vector_type(4)))unsigned;
constexpr int BATCH=2,NHEAD=16,SEQ=16384,D=64,DM=NHEAD*D,ODM=2048;
constexpr int NW=8,NA=4,QBLK=32,QB=QBLK*NW,KVBLK=64,NQB=SEQ/QB;
constexpr int ATTN_PITCH=DM, ATTN_UNIT_ROWS=QB;
__device__ __forceinline__ int crow(int r,int hi){return (r&3)+8*(r>>2)+4*hi;}
#define SBAR() __builtin_amdgcn_sched_barrier(0)
typedef __attribute__((address_space(3))) const float* lds_cfptr;
#ifndef CM_VAR
#define CM_VAR 0
#endif
#ifndef CM_GRP
#define CM_GRP 16
#endif
__device__ __forceinline__ int med3i(int a,int lo,int hi){ return a<lo?lo:(a>hi?hi:a); }
__device__ __forceinline__ void cmask(f32x16&p0,f32x16&p1,int jb,int qrel,int hi,lds_cfptr bt){
  const float NEG=-INFINITY;
#if CM_VAR==0
  const int kb=64*jb+4*hi; const int qlim=(qrel|63)-kb; const int base=kb-qrel+128;
  #pragma unroll
  for(int r=0;r<16;++r){const int ko=(r&3)+8*(r>>2);
    const float b0=bt[med3i(base+ko,0,192)], b1=bt[med3i(base+ko+32,0,192)];
    p0[r]=(ko>qlim)?NEG:p0[r]+b0; p1[r]=(ko+32>qlim)?NEG:p1[r]+b1;
    if((r%CM_GRP)==CM_GRP-1)__builtin_amdgcn_sched_barrier(0); }
#elif CM_VAR==1
  int kb=64*jb+4*hi; const int ql=qrel|63;
  #pragma unroll
  for(int r=0;r<16;++r){int kv=kb+(r&3)+8*(r>>2); if(kv>ql)p0[r]=NEG; if(kv+32>ql)p1[r]=NEG;}
#elif CM_VAR==2
  lds_cfptr bp = bt + (64*jb+4*hi-qrel+320); const int qlim=(qrel|63)-(64*jb+4*hi);
  #pragma unroll
  for(int r=0;r<16;++r){const int ko=(r&3)+8*(r>>2);
    const float b0=bp[ko], b1=bp[ko+32];
    p0[r]=(ko>qlim)?NEG:p0[r]+b0; p1[r]=(ko+32>qlim)?NEG:p1[r]+b1;
    if((r&3)==3)__builtin_amdgcn_sched_barrier(0); }
#endif
}

constexpr int NSLOT=3, SLOTB=8192;
constexpr int VSLOTB=2*SLOTB;
constexpr int NVSLOT=4;
constexpr int LDS_K=0, LDS_V=NSLOT*SLOTB, LDS_WS=LDS_V+NVSLOT*VSLOTB, LDS_BYTES=LDS_WS+NW*64*4;
constexpr float C2=0.125f*1.4426950408889634f;
__device__ __forceinline__ void glds16(const void*gsrc,unsigned lds_dst){unsigned keep;
  asm volatile("s_mov_b32 %0, m0\n\ts_mov_b32 m0, %2\n\ts_nop 0\n\tglobal_load_lds_dwordx4 %1, off\n\ts_mov_b32 m0, %0":"=&s"(keep):"v"(gsrc),"s"(lds_dst):"memory");}
__device__ __forceinline__ float max3f(float a,float b,float c){float r;asm("v_max3_f32 %0, %1, %2, %3":"=v"(r):"v"(a),"v"(b),"v"(c));return r;}
__device__ __forceinline__ float max2f(float a,float b){float r;asm("v_max_f32_e32 %0, %1, %2":"=v"(r):"v"(a),"v"(b));return r;}
__device__ __forceinline__ float fadd_s(float a,float b){float r;asm("v_add_f32_e32 %0, %1, %2":"=v"(r):"v"(a),"v"(b));return r;}
__device__ __forceinline__ float fsub_s(float a,float b){float r;asm("v_sub_f32_e32 %0, %1, %2":"=v"(r):"v"(a),"v"(b));return r;}
typedef float f32x2_t __attribute__((ext_vector_type(2))); typedef __bf16 bf16x2_t __attribute__((ext_vector_type(2)));
__device__ __forceinline__ unsigned cvtpk_s(float lo,float hi){f32x2_t v={lo,hi};bf16x2_t b=__builtin_convertvector(v,bf16x2_t);return __builtin_bit_cast(unsigned,b);}
#define WAIT_BAR(N) asm volatile("s_waitcnt vmcnt(" #N ") lgkmcnt(0)\n\ts_barrier":::"memory")

__device__ __forceinline__ void qkt(f32x16&p0,f32x16&p1,const char*Kslot,const bf16x8*qr,const f32x16&negm,int r32,int hi){
  const char*kb=Kslot+hi*1024+r32*16;
  #pragma unroll
  for(int d0=0;d0<4;++d0){
    const bf16x8 b0=*reinterpret_cast<const bf16x8*>(kb+d0*2048);
    const bf16x8 b1=*reinterpret_cast<const bf16x8*>(kb+d0*2048+512);
    if(d0==0){p0=__builtin_amdgcn_mfma_f32_32x32x16_bf16(b0,qr[0],negm,0,0,0);p1=__builtin_amdgcn_mfma_f32_32x32x16_bf16(b1,qr[0],negm,0,0,0);}
    else{p0=__builtin_amdgcn_mfma_f32_32x32x16_bf16(b0,qr[d0],p0,0,0,0);p1=__builtin_amdgcn_mfma_f32_32x32x16_bf16(b1,qr[d0],p1,0,0,0);}}
}
typedef __attribute__((address_space(3))) const char* lds_cptr;
typedef short v4i16_t __attribute__((ext_vector_type(4)));
__device__ __forceinline__ void kload8(bf16x8*kf,lds_cptr kp){
  kf[0]=*(const __attribute__((address_space(3))) bf16x8*)(kp);      kf[1]=*(const __attribute__((address_space(3))) bf16x8*)(kp+512);
  kf[2]=*(const __attribute__((address_space(3))) bf16x8*)(kp+2048); kf[3]=*(const __attribute__((address_space(3))) bf16x8*)(kp+2560);
  kf[4]=*(const __attribute__((address_space(3))) bf16x8*)(kp+4096); kf[5]=*(const __attribute__((address_space(3))) bf16x8*)(kp+4608);
  kf[6]=*(const __attribute__((address_space(3))) bf16x8*)(kp+6144); kf[7]=*(const __attribute__((address_space(3))) bf16x8*)(kp+6656);
}
__device__ __forceinline__ void kload2(bf16x8*kf,lds_cptr kp,int j){ kf[2*j]=*(const __attribute__((address_space(3))) bf16x8*)(kp+j*2048); kf[2*j+1]=*(const __attribute__((address_space(3))) bf16x8*)(kp+j*2048+512); }
__device__ __forceinline__ s16x4 vtr(lds_cptr p){ return __builtin_bit_cast(s16x4,__builtin_amdgcn_ds_read_tr16_b64_v4i16((__attribute__((address_space(3))) v4i16_t*)p)); }
__device__ __forceinline__ float rowmax(const f32x16&p0,const f32x16&p1){
  float a=max3f(p0[0],p0[1],p1[0]),b=max3f(p0[2],p0[3],p1[1]);a=max3f(a,p1[2],p1[3]);
  #pragma unroll
  for(int r=4;r<16;r+=4){a=max3f(a,p0[r],p0[r+1]);b=max3f(b,p0[r+2],p0[r+3]);a=max3f(a,p1[r],p1[r+1]);b=max3f(b,p1[r+2],p1[r+3]);}
  const float m=max2f(a,b);
  auto rr=__builtin_amdgcn_permlane32_swap(__float_as_uint(m),__float_as_uint(m),false,false);
  return max2f(__uint_as_float(rr[0]),__uint_as_float(rr[1]));
}
__device__ __forceinline__ void pv(f32x16*o,int vb,bf16x8 pa0,bf16x8 pa1,bf16x8 pa2,bf16x8 pa3){
  #pragma unroll
  for(int d0=0;d0<2;++d0){s16x4 lo[4],hi[4];
    #pragma unroll
    for(int ks=0;ks<4;++ks){
      asm volatile("ds_read_b64_tr_b16 %0,%1 offset:%c2":"=&v"(lo[ks]):"v"(vb),"i"(d0*4096+ks*1024):"memory");
      asm volatile("ds_read_b64_tr_b16 %0,%1 offset:%c2":"=&v"(hi[ks]):"v"(vb),"i"(d0*4096+ks*1024+512):"memory");}
    asm volatile("s_waitcnt lgkmcnt(0)":::"memory");SBAR();
    #define PK(k) (bf16x8){lo[k][0],lo[k][1],lo[k][2],lo[k][3],hi[k][0],hi[k][1],hi[k][2],hi[k][3]}
    o[d0]=__builtin_amdgcn_mfma_f32_32x32x16_bf16(pa0,PK(0),o[d0],0,0,0);
    o[d0]=__builtin_amdgcn_mfma_f32_32x32x16_bf16(pa1,PK(1),o[d0],0,0,0);
    o[d0]=__builtin_amdgcn_mfma_f32_32x32x16_bf16(pa2,PK(2),o[d0],0,0,0);
    o[d0]=__builtin_amdgcn_mfma_f32_32x32x16_bf16(pa3,PK(3),o[d0],0,0,0);
    #undef PK
  }
}

__device__ __forceinline__ void pv4(f32x16*o,int vb,bf16x8 pa0,bf16x8 pa1,bf16x8 pa2,bf16x8 pa3){
  s16x4 lo[2][4],hi[2][4];
  #define RD8(set,ks) do{ _Pragma("unroll") for(int d0=0;d0<4;++d0){ \
      asm volatile("ds_read_b64_tr_b16 %0,%1 offset:%c2":"=&v"(lo[set][d0]):"v"(vb),"i"(d0*4096+(ks)*1024):"memory"); \
      asm volatile("ds_read_b64_tr_b16 %0,%1 offset:%c2":"=&v"(hi[set][d0]):"v"(vb),"i"(d0*4096+(ks)*1024+512):"memory");} }while(0)
  #define PK(set,k) (bf16x8){lo[set][k][0],lo[set][k][1],lo[set][k][2],lo[set][k][3],hi[set][k][0],hi[set][k][1],hi[set][k][2],hi[set][k][3]}
  #define MM4(set,pa) do{ o[0]=__builtin_amdgcn_mfma_f32_32x32x16_bf16(pa,PK(set,0),o[0],0,0,0); o[1]=__builtin_amdgcn_mfma_f32_32x32x16_bf16(pa,PK(set,1),o[1],0,0,0); \
      o[2]=__builtin_amdgcn_mfma_f32_32x32x16_bf16(pa,PK(set,2),o[2],0,0,0); o[3]=__builtin_amdgcn_mfma_f32_32x32x16_bf16(pa,PK(set,3),o[3],0,0,0); }while(0)
  RD8(0,0);
  RD8(1,1); asm volatile("s_waitcnt lgkmcnt(8)":::"memory"); SBAR(); MM4(0,pa0); SBAR();
  RD8(0,2); asm volatile("s_waitcnt lgkmcnt(8)":::"memory"); SBAR(); MM4(1,pa1); SBAR();
  RD8(1,3); asm volatile("s_waitcnt lgkmcnt(8)":::"memory"); SBAR(); MM4(0,pa2); SBAR();
  asm volatile("s_waitcnt lgkmcnt(0)":::"memory"); SBAR(); MM4(1,pa3);
  #undef RD8
  #undef PK
  #undef MM4
}
#ifndef ATTN_STORE16
#define ATTN_STORE16(p,v) (*(u32x4*)(p)=(v))
#endif
template<int THRL> __device__ __forceinline__ void attn_unit(int b,int h,int qb,const bf16*Q,const bf16*__restrict__ K,const bf16*__restrict__ V,bf16*O,char*shm,lds_cfptr bt,const int wid_in){
  const int wid=wid_in,lane=fresh_lane(),r32=lane&31,hi=lane>>5;
  const long rowbase=(long)b*SEQ; const int q0=qb*QB;
  const bf16*Kh=K+rowbase*DM+h*D,*Vh=V+rowbase*DM+(h>>1)*128;
  const unsigned lds0=(unsigned)(uintptr_t)shm;
  const bf16*ksrc=Kh+(long)lane*DM+wid*8;
  const bf16*vsrc=Vh+(long)(16*(wid&3)+(lane>>2))*DM+(wid>>2)*32+(lane&3)*8;
  const unsigned kdst=lds0+LDS_K+wid*1024, vdst=lds0+LDS_V+wid*1024;
  #define DMA_K(t,slot) glds16(ksrc+(long)(t)*KVBLK*DM,(unsigned)__builtin_amdgcn_readfirstlane(kdst+(slot)))
  #define VOFF(t) ((int)(((t)&(NVSLOT-1))*VSLOTB))
  #define DMA_V(t) do{ glds16(vsrc+(long)(t)*KVBLK*DM,(unsigned)__builtin_amdgcn_readfirstlane(vdst+VOFF(t))); glds16(vsrc+64+(long)(t)*KVBLK*DM,(unsigned)__builtin_amdgcn_readfirstlane(vdst+VOFF(t)+8192)); }while(0)
  typedef __attribute__((address_space(3))) char* lds_ptr; typedef __attribute__((address_space(3))) float* lds_fptr;
  const lds_ptr shm3=(lds_ptr)shm;
  const lds_fptr wsf=(lds_fptr)(shm3+LDS_WS+wid*256);
  const int NT=(q0+QB)/KVBLK;
  int sl_prev=0,sl_cur=0,sl_next=SLOTB;
  #define ROT() do{sl_prev=sl_cur;sl_cur=sl_next;sl_next=(sl_next==(NSLOT-1)*SLOTB)?0:sl_next+SLOTB;}while(0)
  #define ENDW(tt) do{ if((tt)+3<NT){WAIT_BAR(3);} else if((tt)+2<NT){WAIT_BAR(2);} else {WAIT_BAR(0);} }while(0)
  DMA_K(0,0);DMA_V(0);DMA_K(1,SLOTB);DMA_V(1);DMA_K(2,2*SLOTB);DMA_V(2);
  const bf16*Qw=Q+(rowbase+q0+wid*QBLK)*DM+h*D;
  bf16x8 qr[4];
  #pragma unroll
  for(int d0=0;d0<4;++d0)qr[d0]=*reinterpret_cast<const bf16x8*>(&Qw[(long)r32*DM+d0*16+hi*8]);
  float mhat=0.f,l_reg=0.f;f32x16 negm;f32x16 o[4];
  _Pragma("unroll") for(int r=0;r<16;++r){float z0,z1,z2,z3,z4; asm volatile("v_mov_b32 %0, 0\n\tv_mov_b32 %1, 0\n\tv_mov_b32 %2, 0\n\tv_mov_b32 %3, 0\n\tv_mov_b32 %4, 0":"=v"(z0),"=v"(z1),"=v"(z2),"=v"(z3),"=v"(z4)); o[0][r]=z0;o[1][r]=z1;o[2][r]=z2;o[3][r]=z3;negm[r]=z4;}
  const int qrel=wid*QBLK+r32;
  const lds_cptr kp0=(lds_cptr)shm3+LDS_K+hi*1024+r32*16;
  const int vb0=(int)(lds0+LDS_V)+((lane>>4)&1)*32+(lane&3)*8+(4*hi+((lane&15)>>2))*64;
  bf16x8 kf[8];
  #define MF(a,b,c) __builtin_amdgcn_mfma_f32_32x32x16_bf16(a,b,c,0,0,0)
  #define MX3(a,b,c) __builtin_fmaxf(__builtin_fmaxf((a),(b)),(c))
  u32x4 pw0,pw1,pw2,pw3;
  #define RD8(set,ks) do{ _Pragma("unroll") for(int d0=0;d0<4;++d0){ \
      asm volatile("ds_read_b64_tr_b16 %0,%1 offset:%c2":"=&v"(vlo_[set][d0]):"v"(vb_),"i"(d0*4096+(ks)*1024):"memory"); \
      asm volatile("ds_read_b64_tr_b16 %0,%1 offset:%c2":"=&v"(vhi_[set][d0]):"v"(vb_),"i"(d0*4096+(ks)*1024+512):"memory");} }while(0)
  #define PK(set,k) (bf16x8){vlo_[set][k][0],vlo_[set][k][1],vlo_[set][k][2],vlo_[set][k][3],vhi_[set][k][0],vhi_[set][k][1],vhi_[set][k][2],vhi_[set][k][3]}
  #define EX2(X,i) do{ X[i]=__builtin_amdgcn_exp2f(X[i]); X[(i)+1]=__builtin_amdgcn_exp2f(X[(i)+1]); sa_+=X[i]; sb_+=X[(i)+1]; asm volatile("":"+v"(sa_),"+v"(sb_)); }while(0)
  #define PVX(set,pw_,X,B) do{ const bf16x8 pa_=__builtin_bit_cast(bf16x8,pw_); \
      o[0]=MF(pa_,PK(set,0),o[0]); EX2(X,(B)+0); asm volatile("":"+v"(X)); SBAR(); \
      o[1]=MF(pa_,PK(set,1),o[1]); EX2(X,(B)+2); asm volatile("":"+v"(X)); SBAR(); \
      o[2]=MF(pa_,PK(set,2),o[2]); EX2(X,(B)+4); asm volatile("":"+v"(X)); SBAR(); \
      o[3]=MF(pa_,PK(set,3),o[3]); EX2(X,(B)+6); asm volatile("":"+v"(X)); SBAR(); }while(0)
  #define ASTEP(s,FIRST,GK,GV,GL,LATE) do{ \
    f32x16 c0=MF(kf[0],qr[0],negm),c1=MF(kf[1],qr[0],negm); c0=MF(kf[2],qr[1],c0);c1=MF(kf[3],qr[1],c1); c0=MF(kf[4],qr[2],c0);c1=MF(kf[5],qr[2],c1); c0=MF(kf[6],qr[3],c0);c1=MF(kf[7],qr[3],c1); \
    if(GK){DMA_K((s)+3,sl_cur);} if(GV){DMA_V((s)+2);} \
    if(GL){kload8(kf,kp0+sl_next);} \
    { const int jb_=(s)-(NT-4); if(jb_>=-2)cmask(c0,c1,jb_,qrel,hi,bt); } \
    float a_=MX3(c0[0],c0[1],c1[0]),b_=MX3(c0[2],c0[3],c1[1]); a_=MX3(a_,c1[2],c1[3]); \
    _Pragma("unroll") for(int r=4;r<16;r+=4){a_=MX3(a_,c0[r],c0[r+1]);b_=MX3(b_,c0[r+2],c0[r+3]);a_=MX3(a_,c1[r],c1[r+1]);b_=MX3(b_,c1[r+2],c1[r+3]);} \
    float rm=__builtin_fmaxf(a_,b_); { auto rr=__builtin_amdgcn_permlane32_swap(__float_as_uint(rm),__float_as_uint(rm),false,false); rm=__builtin_fmaxf(__uint_as_float(rr[0]),__uint_as_float(rr[1])); } \
    bool resc_=false; \
    if(FIRST){ const float dl=rm; mhat+=dl; _Pragma("unroll") for(int r=0;r<16;++r){c0[r]-=dl;c1[r]-=dl;} _Pragma("unroll") for(int r=0;r<16;++r)negm[r]=-mhat; asm volatile("":"+v"(negm)); } \
    else if(__builtin_expect(__any(rm>(float)THRL),0)){ const float dl=__builtin_fmaxf(rm,0.f); mhat+=dl; \
      _Pragma("unroll") for(int r=0;r<16;++r){c0[r]-=dl;c1[r]-=dl;} _Pragma("unroll") for(int r=0;r<16;++r)negm[r]=-mhat; asm volatile("":"+v"(negm)); \
      const float f=__builtin_amdgcn_exp2f(-dl); l_reg*=f; if(hi==0)wsf[r32]=f; resc_=true; } \
    float sa_=0.f,sb_=0.f; \
    if(FIRST){ _Pragma("unroll") for(int r=0;r<16;++r){c0[r]=__builtin_amdgcn_exp2f(c0[r]);c1[r]=__builtin_amdgcn_exp2f(c1[r]);sa_+=c0[r];sb_+=c1[r];} } \
    else { s16x4 vlo_[2][4],vhi_[2][4]; const int vb_=vb0+VOFF((s)-1); \
      SBAR(); \
      RD8(0,0); \
      RD8(1,1); asm volatile("s_waitcnt lgkmcnt(8)":::"memory"); SBAR(); PVX(0,pw0,c0,0); \
      RD8(0,2); asm volatile("s_waitcnt lgkmcnt(8)":::"memory"); SBAR(); PVX(1,pw1,c0,8); \
      RD8(1,3); asm volatile("s_waitcnt lgkmcnt(8)":::"memory"); SBAR(); PVX(0,pw2,c1,0); \
      asm volatile("s_waitcnt lgkmcnt(0)":::"memory"); SBAR(); PVX(1,pw3,c1,8); \
      if(resc_){ _Pragma("unroll") for(int r=0;r<16;++r){ const float f_=wsf[crow(r,hi)]; o[0][r]*=f_;o[1][r]*=f_;o[2][r]*=f_;o[3][r]*=f_; } } } \
    l_reg+=sa_+sb_; \
    pw0=(u32x4){cvtpk_s(c0[0],c0[1]),cvtpk_s(c0[2],c0[3]),cvtpk_s(c0[4],c0[5]),cvtpk_s(c0[6],c0[7])}; pw1=(u32x4){cvtpk_s(c0[8],c0[9]),cvtpk_s(c0[10],c0[11]),cvtpk_s(c0[12],c0[13]),cvtpk_s(c0[14],c0[15])}; \
    pw2=(u32x4){cvtpk_s(c1[0],c1[1]),cvtpk_s(c1[2],c1[3]),cvtpk_s(c1[4],c1[5]),cvtpk_s(c1[6],c1[7])}; pw3=(u32x4){cvtpk_s(c1[8],c1[9]),cvtpk_s(c1[10],c1[11]),cvtpk_s(c1[12],c1[13]),cvtpk_s(c1[14],c1[15])}; \
  }while(0)
  WAIT_BAR(3);
  kload8(kf,kp0);
  #define STEPS(LATE) do{ \
    ASTEP(0,true,false,false,true,LATE);                      \
    WAIT_BAR(0);                                              \
    DMA_K(3,0);                                               \
    ROT(); \
    int t=1; \
    for(;t+7<NT;t+=2){ \
      ASTEP(t,false,true,true,true,LATE);     WAIT_BAR(3); ROT(); \
      ASTEP(t+1,false,true,true,true,LATE);   WAIT_BAR(3); ROT(); \
    } \
    for(;t+1<NT;t+=2){ \
      ASTEP(t,false,(t+3<NT),(t+2<NT),(t+1<NT),LATE);       ENDW(t);   ROT(); \
      ASTEP(t+1,false,(t+4<NT),(t+3<NT),(t+2<NT),LATE);     ENDW(t+1); ROT(); \
    } \
    ASTEP(NT-1,false,false,false,false,LATE); \
    if(LATE){ pv4(o,vb0+VOFF(NT-1),__builtin_bit_cast(bf16x8,pw0),__builtin_bit_cast(bf16x8,pw1),__builtin_bit_cast(bf16x8,pw2),__builtin_bit_cast(bf16x8,pw3)); } \
  }while(0)
  if(wid>=4) __builtin_amdgcn_s_setprio(1);
  STEPS(true);
  __builtin_amdgcn_s_setprio(0);
  #undef STEPS
  #undef ASTEP
  #undef PVX
  #undef EX2
  #undef PK
  #undef RD8
  #undef MF
  #undef MX3
  {auto rr=__builtin_amdgcn_permlane32_swap(__float_as_uint(l_reg),__float_as_uint(l_reg),false,false);l_reg=__uint_as_float(rr[0])+__uint_as_float(rr[1]);}
  if(hi==0)wsf[32+r32]=l_reg;
  asm volatile("s_waitcnt vmcnt(0) lgkmcnt(0)\n\ts_barrier":::"memory");
  float rli[16];
  #pragma unroll
  for(int r=0;r<16;++r)rli[r]=__builtin_amdgcn_rcpf(wsf[32+crow(r,hi)]);
  bf16*Ow=O+(rowbase+q0+wid*QBLK)*ODM+h*128;
  { bf16*stg=(bf16*)(shm+wid*8192);
    #pragma unroll
    for(int r=0;r<16;++r){const int orow=crow(r,hi);
      #pragma unroll
      for(int d0=0;d0<4;++d0)stg[orow*128+d0*32+r32]=__float2bfloat16(o[d0][r]*rli[r]);}
    asm volatile("s_waitcnt lgkmcnt(0)":::"memory");
    #pragma unroll
    for(int i=0;i<8;++i){const int row=i*4+(lane>>4),ch=lane&15; const u32x4 v=*(const u32x4*)(stg+row*128+ch*8); ATTN_STORE16(Ow+(long)row*ODM+ch*8,v);} }
  asm volatile("s_waitcnt lgkmcnt(0)\n\ts_barrier":::"memory");
  #undef DMA_K
  #undef DMA_V
  #undef VOFF
  #undef ROT
  #undef ENDW
}
constexpr int ATTN_LDS_BYTES=LDS_BYTES;
#undef SBAR
#undef WAIT_BAR
}
#define LAS __attribute__((address_space(3)))
typedef unsigned short bf16;
typedef unsigned v4u __attribute__((ext_vector_type(4)));
typedef unsigned v2u __attribute__((ext_vector_type(2)));
typedef float f32x4 __attribute__((ext_vector_type(4)));
typedef short bf16x8 __attribute__((ext_vector_type(8)));
typedef float f32x16 __attribute__((ext_vector_type(16)));
#define LDS_WAIT() asm volatile("s_waitcnt lgkmcnt(0)" ::: "memory")
constexpr int NWAVES = 8, NTHR = 512;
constexpr int D = 2048, MROWS = 33792, MP = 32768, NIN = 5120, DFF = 5632;
constexpr float EPS = 1e-6f, LOG2E = 1.4426950408889634f;
constexpr size_t MiB = 1u << 20;
constexpr size_t WS_BAR = 983040, WS_MOD = 0, WS_MODF = 1 * MiB, WS_WIN = 2 * MiB, WS_WOUT = 22 * MiB, WS_WFI = 30 * MiB, WS_WFO = 74 * MiB, WS_H = 96 * MiB, WS_CAT = 228 * MiB,
                 WS_U = 360 * MiB, WS_G = 426 * MiB, WS_Q = 492 * MiB, WS_K = 558 * MiB, WS_V = 624 * MiB, WS_O = 690 * MiB, WS_F = 228 * MiB, WS_X1B = 690 * MiB, WS_X2B = 96 * MiB, WS_PART = 822 * MiB, WS_END = 854 * MiB;
constexpr long OUT_Y = 0, OUT_GVS = 138412032L;
constexpr int LDS_BYTES = 147456, RING_BYTES = 131072, BT_OFF = 126976;
static_assert(attn_body::ATTN_LDS_BYTES <= BT_OFF && BT_OFF + 8 * 196 * 4 <= LDS_BYTES, "LDS map");

__device__ __forceinline__ unsigned f2bf(float f) { unsigned u = __builtin_bit_cast(unsigned, f); return (u + 0x7fffu + ((u >> 16) & 1u)) >> 16; }
typedef float f32x2_pk __attribute__((ext_vector_type(2))); typedef __bf16 bf16x2_pk __attribute__((ext_vector_type(2)));
__device__ __forceinline__ unsigned pk2(float lo, float hi) { f32x2_pk v = {lo, hi}; bf16x2_pk b = __builtin_convertvector(v, bf16x2_pk); return __builtin_bit_cast(unsigned, b); }
__device__ __forceinline__ float bf2f(unsigned short h) { return __builtin_bit_cast(float, (unsigned)h << 16); }
__device__ __forceinline__ float bflo(unsigned w) { return __builtin_bit_cast(float, w << 16); }
__device__ __forceinline__ float bfhi(unsigned w) { return __builtin_bit_cast(float, w & 0xffff0000u); }
__device__ __forceinline__ float wave_sum(float v) {
#pragma unroll
    for (int o = 1; o < 64; o <<= 1) v += __shfl_xor(v, o);
    return v;
}
__device__ __forceinline__ int row_batch(int row) { return row < MP ? (row >> 14) : 2 + ((row - MP) >> 6); }

struct Args { const float* in[27]; float* out; unsigned char* ws; int ph_lo, ph_hi; };
enum { I_XP = 0, I_XS, I_CK, I_CV, I_CP, I_CS, I_RB, I_WADA, I_BADA, I_WADAF, I_BADAF, I_GMIX, I_GFFN, I_GFIN, I_WIN, I_LNG, I_LNB, I_WS, I_BS, I_LQ1, I_LK1, I_LQ2, I_LK2, I_SUBG, I_WOUT, I_WFI, I_WFO };

__device__ __forceinline__ void p0_transpose_item(const float* W, int K, int N, bf16* WT, int mode, LAS float* scr, int item, int lane) {
    const int nblk = N / 64, kb = item / nblk, nb = item % nblk, k0 = 64 * kb, n0 = 64 * nb;
    int rbase = n0;
    if (mode == 1) { const int j = n0 < DFF ? n0 : n0 - DFF; rbase = (j >> 7) * 256 + (n0 < DFF ? 0 : 128) + (j & 127); }
    const float* src = W + (size_t)k0 * N + n0 + lane;
    float wv[64];
#pragma unroll
    for (int i = 0; i < 64; ++i) wv[i] = src[(size_t)i * N];
#pragma unroll
    for (int i = 0; i < 64; ++i) scr[i * 65 + lane] = wv[i];
    LDS_WAIT(); asm volatile("" ::: "memory");
    const int c = lane & 7;
#pragma unroll
    for (int j = 0; j < 8; ++j) { const int n = (lane >> 3) + 8 * j; const LAS float* s = scr + (8 * c) * 65 + n;
        v4u o; o.x = pk2(s[0 * 65], s[1 * 65]); o.y = pk2(s[2 * 65], s[3 * 65]); o.z = pk2(s[4 * 65], s[5 * 65]); o.w = pk2(s[6 * 65], s[7 * 65]);
        *(v4u*)(WT + (size_t)(rbase + n) * K + k0 + 8 * c) = o; }
    LDS_WAIT(); asm volatile("" ::: "memory");
}
__device__ __forceinline__ void adaln_unit(const Args& a, LAS unsigned char* lds, int unit, int tid, int wave, int lane) {
    LAS float* sc = (LAS float*)lds;
    LAS float* red = (LAS float*)(lds + 18 * 1024 * 4);
    const int j0 = unit * 64; const bool fin = j0 >= 12288;
    const float* W = fin ? a.in[I_WADAF] : a.in[I_WADA]; const int N = fin ? 4096 : 12288; const int jc = (fin ? j0 - 12288 : j0) + lane;
    float acc[18];
#pragma unroll
    for (int r = 0; r < 18; ++r) acc[r] = 0.f;
    for (int kh = 0; kh < 2; ++kh) {
        __syncthreads();
        for (int i = tid; i < 18 * 1024; i += NTHR) { const int r = i >> 10, k = (i & 1023) + kh * 1024; const float c = r < 2 ? a.in[I_CP][r * 2048 + k] : a.in[I_CS][(r - 2) * 2048 + k];
            sc[i] = c / (1.0f + __expf(-c)); }
        __syncthreads();
        const int kb = wave * 128;
        for (int k = 0; k < 128; k += 16) {
            float w[16];
#pragma unroll
            for (int e = 0; e < 16; ++e) w[e] = W[(size_t)(kh * 1024 + kb + k + e) * N + jc];
#pragma unroll
            for (int q = 0; q < 4; ++q)
#pragma unroll
                for (int r = 0; r < 18; ++r) { const f32x4 s = *(const LAS f32x4*)(sc + r * 1024 + kb + k + 4 * q); acc[r] += s[0] * w[4 * q] + s[1] * w[4 * q + 1] + s[2] * w[4 * q + 2] + s[3] * w[4 * q + 3]; }
        }
    }
#pragma unroll
    for (int r = 0; r < 18; ++r) red[(wave * 18 + r) * 64 + lane] = acc[r];
    __syncthreads();
    for (int i = tid; i < 18 * 64; i += NTHR) { const int r = i >> 6, l = i & 63; float s = 0.f;
#pragma unroll
        for (int w = 0; w < 8; ++w) s += red[(w * 18 + r) * 64 + l];
        const int j = (fin ? j0 - 12288 : j0) + l;
        if (fin) ((float*)(a.ws + WS_MODF))[r * 4096 + j] = s + a.in[I_BADAF][j]; else ((float*)(a.ws + WS_MOD))[r * 12288 + j] = s + a.in[I_BADA][j]; }
    __syncthreads();
}
__device__ __forceinline__ void p0_prologue(const Args& a, LAS unsigned char* lds, int vcu, int G, int tid, int wave, int lane) {
    for (int rp = 0, nrp = opaque_i(((PROBE_REP >> 12) & 1) ? 2 : 1); rp < nrp; ++rp)
    for (int u = vcu; u < 256; u += G) adaln_unit(a, lds, u, tid, wave, lane);
    LAS float* scr = (LAS float*)(lds + wave * 17408);
    const int gw = vcu * NWAVES + wave, NGW = G * NWAVES;
    constexpr int I_1 = (D / 64) * (NIN / 64), I_2 = (D / 64) * (D / 64), I_3 = (D / 64) * (2 * DFF / 64), I_4 = (DFF / 64) * (D / 64);
    for (int it = gw; it < I_1 + I_2 + I_3 + I_4; it += NGW) {
        int r = it;
        if (r < I_1) { p0_transpose_item(a.in[I_WIN], D, NIN, (bf16*)(a.ws + WS_WIN), 0, scr, r, lane); continue; } r -= I_1;
        if (r < I_2) { p0_transpose_item(a.in[I_WOUT], D, D, (bf16*)(a.ws + WS_WOUT), 0, scr, r, lane); continue; } r -= I_2;
        if (r < I_3) { p0_transpose_item(a.in[I_WFI], D, 2 * DFF, (bf16*)(a.ws + WS_WFI), 1, scr, r, lane); continue; } r -= I_3;
        p0_transpose_item(a.in[I_WFO], DFF, D, (bf16*)(a.ws + WS_WFO), 0, scr, r, lane);
    }
}
template <bool F32OUT> __device__ __forceinline__ void norm_mod_rows(const float* fp, const float* fs, const bf16* bp, const bf16* bs, const float* g, const float* shift, const float* scale, int mstride, void* dst, int gw, int NGW, int lane, const float* part = nullptr, bf16* wb = nullptr) {
#define NM_SRC(ROW, SRCF, SRCB) const bool smp_##ROW = (ROW) >= MP; \
        const float* SRCF = smp_##ROW ? (fs ? fs + (size_t)((ROW) - MP) * D : nullptr) : (fp ? fp + (size_t)(ROW) * D : nullptr); \
        const bf16* SRCB = (smp_##ROW ? bs : bp) + (size_t)(ROW) * D
#define NM_LOAD(SRCF, SRCB, RF, RB) do { if (SRCF) { _Pragma("unroll") for (int j = 0; j < 8; ++j) RF[j] = *(const f32x4*)(SRCF + 4 * lane + 256 * j); } \
        else { _Pragma("unroll") for (int j = 0; j < 8; ++j) RB[j] = *(const v2u*)(SRCB + 4 * lane + 256 * j); } } while (0)
#define NM_PROC(ROW, SRCF, RF, RB) do { const int row = (ROW); const bool smp = row >= MP; const int b = row_batch(row); f32x4 v[8]; float s = 0.f; \
        if (SRCF) { _Pragma("unroll") for (int j = 0; j < 8; ++j) v[j] = RF[j]; } \
        else { _Pragma("unroll") for (int j = 0; j < 8; ++j) v[j] = (f32x4){bflo(RB[j].x), bfhi(RB[j].x), bflo(RB[j].y), bfhi(RB[j].y)}; } \
        if (part && smp) { \
            _Pragma("unroll") for (int sp = 0; sp < 4; ++sp) { const float* pp = part + ((size_t)sp * (MROWS - MP) + (size_t)(row - MP)) * D + 4 * lane; \
                _Pragma("unroll") for (int j = 0; j < 8; ++j) v[j] += *(const f32x4*)(pp + 256 * j); } \
            if (wb) { _Pragma("unroll") for (int j = 0; j < 8; ++j) { v2u w; w.x = pk2(v[j][0], v[j][1]); w.y = pk2(v[j][2], v[j][3]); *(v2u*)(wb + (size_t)row * D + 4 * lane + 256 * j) = w; } } } \
        _Pragma("unroll") for (int j = 0; j < 8; ++j) s += (v[j][0] * v[j][0] + v[j][1] * v[j][1]) + (v[j][2] * v[j][2] + v[j][3] * v[j][3]); \
        const float rstd = 1.0f / sqrtf(wave_sum(s) * (1.0f / D) + EPS); \
        _Pragma("unroll") for (int j = 0; j < 8; ++j) { const int col = 4 * lane + 256 * j; \
            const f32x4 gg = *(const f32x4*)(g + col), sh = *(const f32x4*)(shift + (size_t)b * mstride + col), sc = *(const f32x4*)(scale + (size_t)b * mstride + col); \
            const f32x4 o = (v[j] * rstd * gg) * (sc + 1.0f) + sh; \
            if (F32OUT) *(f32x4*)((float*)dst + (size_t)row * D + col) = o; \
            else { v2u w; w.x = pk2(o[0], o[1]); w.y = pk2(o[2], o[3]); *(v2u*)((bf16*)dst + (size_t)row * D + col) = w; } } } while (0)
    for (int row0 = gw; row0 < MROWS; row0 += 2 * NGW) {
        const int row1 = row0 + NGW; const bool has1 = row1 < MROWS;
        f32x4 rf0[8], rf1[8]; v2u rb0[8], rb1[8];
        NM_SRC(row0, sf0, sb0); NM_SRC(row1, sf1, sb1);
        NM_LOAD(sf0, sb0, rf0, rb0);
        if (has1) NM_LOAD(sf1, sb1, rf1, rb1);
        NM_PROC(row0, sf0, rf0, rb0);
        if (has1) NM_PROC(row1, sf1, rf1, rb1);
    }
#undef NM_SRC
#undef NM_LOAD
#undef NM_PROC
}
__device__ __forceinline__ float diff_lambda(const Args& a, int lane) {
    const float s1 = wave_sum(a.in[I_LQ1][lane] * a.in[I_LK1][lane]), s2 = wave_sum(a.in[I_LQ2][lane] * a.in[I_LK2][lane]);
    return __expf(s1) - __expf(s2) + 0.2f;
}
__device__ __forceinline__ void bias_table(const Args& a, LAS float* bt, int tid) {
    for (int i = tid; i < 8 * 193; i += NTHR) { const int h = i / 193, idx = i % 193, rel = idx - 128, n = rel < 0 ? -rel : rel;
        int bk; if (n < 8) bk = n; else { const int q = (n * n) >> 6; bk = 8 + (31 - __clz(q)); if (bk > 15) bk = 15; }
        if (rel > 0) bk += 16;
        bt[h * 196 + idx] = (a.in[I_RB][bk * 8 + h] - a.in[I_RB][15 * 8 + h]) * LOG2E; }
}
__device__ __forceinline__ int crow(int r, int hi) { return (r & 3) + 8 * (r >> 2) + 4 * hi; }
__device__ __forceinline__ bf16x8 cvt8(f32x4 a, f32x4 b) { v4u w; w.x = pk2(a[0], a[1]); w.y = pk2(a[2], a[3]); w.z = pk2(b[0], b[1]); w.w = pk2(b[2], b[3]); return __builtin_bit_cast(bf16x8, w); }

constexpr int TSTR = 136;
__device__ __forceinline__ void unpack16(const v4u w0, const v4u w1, float* v) {
    v[0] = bflo(w0.x); v[1] = bfhi(w0.x); v[2] = bflo(w0.y); v[3] = bfhi(w0.y); v[4] = bflo(w0.z); v[5] = bfhi(w0.z); v[6] = bflo(w0.w); v[7] = bfhi(w0.w);
    v[8] = bflo(w1.x); v[9] = bfhi(w1.x); v[10] = bflo(w1.y); v[11] = bfhi(w1.y); v[12] = bflo(w1.z); v[13] = bfhi(w1.z); v[14] = bflo(w1.w); v[15] = bfhi(w1.w);
}
__device__ __forceinline__ void sgate_unit(const Args& a, LAS unsigned char* lds, int c, int tid, int wave, int lane) {
    asm volatile("" : "+v"(lane), "+v"(tid));
    const bool smp = c >= 256; const int T = smp ? 64 : 128; const int row0 = smp ? MP + 64 * (c - 256) : 128 * c;
    const bf16* Gb = (const bf16*)(a.ws + WS_G); const bf16* Ub = (const bf16*)(a.ws + WS_U); bf16* CAT = (bf16*)(a.ws + WS_CAT);
    LAS bf16* tile0 = (LAS bf16*)lds;
    LAS float* stats = (LAS float*)(lds + 2 * 128 * TSTR * 2);
    __syncthreads();
    for (int rb = 0; rb < 16; rb += 4) { const int rbase = wave * 16 + rb; if (rbase >= T) break;
        v4u w[4][2];
#pragma unroll
        for (int q = 0; q < 4; ++q) { const v4u* gp = (const v4u*)(Gb + (size_t)(row0 + rbase + q) * 1024 + lane * 16); w[q][0] = gp[0]; w[q][1] = gp[1]; }
        float s1[4], s2[4];
#pragma unroll
        for (int q = 0; q < 4; ++q) { float v[16]; unpack16(w[q][0], w[q][1], v); s1[q] = 0.f; s2[q] = 0.f;
#pragma unroll
            for (int e = 0; e < 16; ++e) { s1[q] += v[e]; s2[q] += v[e] * v[e]; } }
#pragma unroll
        for (int o = 1; o < 64; o <<= 1) {
#pragma unroll
            for (int q = 0; q < 4; ++q) { s1[q] += __shfl_xor(s1[q], o); s2[q] += __shfl_xor(s2[q], o); } }
#pragma unroll
        for (int q = 0; q < 4; ++q) { const float mean = s1[q] * (1.0f / 1024.0f); const float var = fmaxf(s2[q] * (1.0f / 1024.0f) - mean * mean, 0.f); const float rstd = 1.0f / sqrtf(var + EPS);
            if (lane == 0) { stats[(rbase + q) * 2] = mean; stats[(rbase + q) * 2 + 1] = rstd; } } }
    __syncthreads();
    const int hi = lane >> 5, r32 = lane & 31, iblk = wave & 3, cpair = wave >> 2;
    const bool act = iblk * 32 < T; const int nks = iblk < 2 ? 4 : 8;
    const int nch = T * 16 / NTHR;
    v4u gpre[4];
#define SG_ISSUE(g) do { _Pragma("unroll") for (int q = 0; q < 4; ++q) if (q < nch) { const int idx = tid + q * NTHR; gpre[q] = *(const v4u*)(Gb + (size_t)(row0 + (idx >> 4)) * 1024 + (g) * 128 + (idx & 15) * 8); } } while (0)
#define SG_COMMIT(g) do { LAS bf16* tl = tile0 + ((g) & 1) * 128 * TSTR; _Pragma("unroll") for (int q = 0; q < 4; ++q) if (q < nch) { const int idx = tid + q * NTHR; const int row = idx >> 4, c8 = (idx & 15) * 8; const v4u w = gpre[q]; \
            const float mean = stats[row * 2], rstd = stats[row * 2 + 1]; \
            const float* lg = a.in[I_LNG] + (g) * 128 + c8; const float* lb = a.in[I_LNB] + (g) * 128 + c8; \
            const f32x4 g0 = *(const f32x4*)lg, g1 = *(const f32x4*)(lg + 4), b0 = *(const f32x4*)lb, b1 = *(const f32x4*)(lb + 4); \
            f32x4 x0 = {bflo(w.x), bfhi(w.x), bflo(w.y), bfhi(w.y)}, x1 = {bflo(w.z), bfhi(w.z), bflo(w.w), bfhi(w.w)}; \
            x0 = (x0 - mean) * rstd * g0 + b0; x1 = (x1 - mean) * rstd * g1 + b1; \
            if (smp) { float* o = a.out + OUT_GVS + (size_t)(row0 - MP + row) * 1024 + (g) * 128 + c8; *(f32x4*)o = x0; *(f32x4*)(o + 4) = x1; } \
            v4u o; o.x = pk2(x0[0], x0[1]); o.y = pk2(x0[2], x0[3]); o.z = pk2(x1[0], x1[1]); o.w = pk2(x1[2], x1[3]); \
            *(LAS v4u*)(tl + row * TSTR + c8) = o; } } while (0)
    SG_ISSUE(0); SG_COMMIT(0);
    __syncthreads();
    for (int g = 0; g < 8; ++g) {
        if (g < 7) SG_ISSUE(g + 1);
        if (act) {
            const LAS bf16* tile = tile0 + (g & 1) * 128 * TSTR;
            const float* wrow = a.in[I_WS] + ((size_t)g * 128 + iblk * 32 + r32) * 128 + 8 * hi;
            f32x4 ar[8][2];
#pragma unroll
            for (int ks = 0; ks < 8; ++ks) if (ks < nks) { ar[ks][0] = *(const f32x4*)(wrow + ks * 16); ar[ks][1] = *(const f32x4*)(wrow + ks * 16 + 4); }
            unsigned uu[16];
#pragma unroll
            for (int r = 0; r < 16; ++r) { const int i = iblk * 32 + crow(r, hi); const size_t ro = (size_t)(row0 + i); const int col = g * 128 + cpair * 64 + r32;
                uu[r] = (unsigned)Ub[ro * 1024 + col] | ((unsigned)Ub[ro * 1024 + col + 32] << 16); }
            f32x16 acc0 = {}, acc1 = {};
#pragma unroll
            for (int ks = 0; ks < 8; ++ks) if (ks < nks) {
                const bf16x8 af = cvt8(ar[ks][0], ar[ks][1]);
                const LAS bf16* tp = tile + (ks * 16 + 8 * hi) * TSTR + cpair * 64 + r32;
                bf16x8 b0, b1;
#pragma unroll
                for (int e = 0; e < 8; ++e) { b0[e] = (short)tp[e * TSTR]; b1[e] = (short)tp[e * TSTR + 32]; }
                acc0 = __builtin_amdgcn_mfma_f32_32x32x16_bf16(af, b0, acc0, 0, 0, 0);
                acc1 = __builtin_amdgcn_mfma_f32_32x32x16_bf16(af, b1, acc1, 0, 0, 0);
            }
#pragma unroll
            for (int r = 0; r < 16; ++r) { const int i = iblk * 32 + crow(r, hi);
                const size_t ro = (size_t)(row0 + i); const int col = g * 128 + cpair * 64 + r32;
                const float bs = a.in[I_BS][g * 128 + i];
                CAT[ro * 2048 + col] = (bf16)f2bf(bflo(uu[r]) * (acc0[r] + bs)); CAT[ro * 2048 + col + 32] = (bf16)f2bf(bfhi(uu[r]) * (acc1[r] + bs)); }
        }
        if (g < 7) SG_COMMIT(g + 1);
        __syncthreads();
    }
#undef SG_ISSUE
#undef SG_COMMIT
}
__device__ __forceinline__ void sattn_unit(const Args& a, LAS unsigned char* lds, const LAS float* bt, int db, int h, int t, int tid, int wave, int lane) {
    asm volatile("" : "+v"(lane), "+v"(tid));
    const int qg = wave & 1, dvh = (wave >> 1) & 1, ksp = wave >> 2, hi = lane >> 5, r32 = lane & 31;
    const bf16* Qb = (const bf16*)(a.ws + WS_Q); const bf16* Kb = (const bf16*)(a.ws + WS_K); const bf16* Vb = (const bf16*)(a.ws + WS_V); bf16* Ob = (bf16*)(a.ws + WS_O);
    const float* CK = a.in[I_CK]; const float* CV = a.in[I_CV];
    const LAS float* bth = bt + h * 196;
    bf16x8 qr[4];
    { const bf16* qp = Qb + (size_t)(MP + db * 64 + qg * 32 + r32) * 1024 + h * 128 + t * 64 + hi * 8;
#pragma unroll
      for (int d0 = 0; d0 < 4; ++d0) qr[d0] = *(const bf16x8*)(qp + d0 * 16); }
    float m = -1e30f, l = 0.f; f32x16 o[2];
    o[0] = f32x16{}; o[1] = f32x16{};
    const unsigned klo = (unsigned)(r32 * 1024 + hi * 8), vlo = (unsigned)(hi * 4096 + dvh * 64 + r32), kco = (unsigned)((lane >> 4) * 1024 + (lane & 15) * 4);
    LAS float* kst = (LAS float*)(lds + 40960 + wave * 8704);
    f32x4 kr[8]; float vr[2][16];
#define SA_LOAD(K0) do { const float* kpu = CK + ((size_t)(db * 2048 + (K0)) * 8 + h) * 128 + t * 64; const float* vpu = CV + ((size_t)(db * 2048 + (K0)) * 8 + h) * 128; \
        _Pragma("unroll") for (int j = 0; j < 8; ++j) kr[j] = *(const f32x4*)(kpu + (kco + j * 4096)); \
        _Pragma("unroll") for (int e = 0; e < 8; ++e) { const float* r0 = vpu + crow(e, 0) * 1024; const float* r1 = vpu + (16 + crow(e, 0)) * 1024; \
            _Pragma("unroll") for (int d2 = 0; d2 < 2; ++d2) { vr[d2][e] = r0[vlo + d2 * 32]; vr[d2][8 + e] = r1[vlo + d2 * 32]; } } } while (0)
#define SA_CVT() do { _Pragma("unroll") for (int j = 0; j < 8; ++j) *(LAS f32x4*)(kst + ((lane >> 4) + 4 * j) * 68 + (lane & 15) * 4) = kr[j]; \
        _Pragma("unroll") for (int d0 = 0; d0 < 4; ++d0) { const LAS float* kp_ = kst + r32 * 68 + d0 * 16 + hi * 8; kf[d0] = cvt8(*(const LAS f32x4*)kp_, *(const LAS f32x4*)(kp_ + 4)); } \
        _Pragma("unroll") for (int d2 = 0; d2 < 2; ++d2) { \
            v4u w0, w1; w0.x = pk2(vr[d2][0], vr[d2][1]); w0.y = pk2(vr[d2][2], vr[d2][3]); w0.z = pk2(vr[d2][4], vr[d2][5]); w0.w = pk2(vr[d2][6], vr[d2][7]); \
            w1.x = pk2(vr[d2][8], vr[d2][9]); w1.y = pk2(vr[d2][10], vr[d2][11]); w1.z = pk2(vr[d2][12], vr[d2][13]); w1.w = pk2(vr[d2][14], vr[d2][15]); \
            vf[d2][0] = __builtin_bit_cast(bf16x8, w0); vf[d2][1] = __builtin_bit_cast(bf16x8, w1); } } while (0)
#define SA_COMPUTE(K0) do { f32x16 s = f32x16{}; \
        _Pragma("unroll") for (int d0 = 0; d0 < 4; ++d0) s = __builtin_amdgcn_mfma_f32_32x32x16_bf16(kf[d0], qr[d0], s, 0, 0, 0); \
        const int relb = (K0) - (2048 + qg * 32 + r32) + 128; float mx = -1e30f; \
        _Pragma("unroll") for (int r = 0; r < 16; ++r) { int idx = relb + crow(r, hi); idx = idx < 0 ? 0 : (idx > 192 ? 192 : idx); s[r] += bth[idx]; mx = fmaxf(mx, s[r]); } \
        mx = fmaxf(mx, __shfl_xor(mx, 32)); \
        const float mn = fmaxf(m, mx); \
        if (__any(mn > m)) { const float alpha = __builtin_amdgcn_exp2f(m - mn); l *= alpha; \
            _Pragma("unroll") for (int r = 0; r < 16; ++r) { const float ar = __shfl(alpha, crow(r, hi)); o[0][r] *= ar; o[1][r] *= ar; } } \
        m = mn; float rs = 0.f; \
        _Pragma("unroll") for (int r = 0; r < 16; ++r) { s[r] = __builtin_amdgcn_exp2f(s[r] - mn); rs += s[r]; } \
        l += rs; \
        v4u p0, p1; p0.x = pk2(s[0], s[1]); p0.y = pk2(s[2], s[3]); p0.z = pk2(s[4], s[5]); p0.w = pk2(s[6], s[7]); \
        p1.x = pk2(s[8], s[9]); p1.y = pk2(s[10], s[11]); p1.z = pk2(s[12], s[13]); p1.w = pk2(s[14], s[15]); \
        const bf16x8 pa0 = __builtin_bit_cast(bf16x8, p0), pa1 = __builtin_bit_cast(bf16x8, p1); \
        _Pragma("unroll") for (int d2 = 0; d2 < 2; ++d2) { \
            o[d2] = __builtin_amdgcn_mfma_f32_32x32x16_bf16(pa0, vf[d2][0], o[d2], 0, 0, 0); \
            o[d2] = __builtin_amdgcn_mfma_f32_32x32x16_bf16(pa1, vf[d2][1], o[d2], 0, 0, 0); } } while (0)
    const int tile0 = ksp * 33, nf = ksp ? 31 : 33;
    SA_LOAD(tile0 * 32);
    for (int it = 0; it < nf; ++it) {
        const int key0 = __builtin_amdgcn_readfirstlane((tile0 + it) * 32);
        bf16x8 kf[4]; bf16x8 vf[2][2];
        SA_CVT();
        if (it + 1 < nf) SA_LOAD(key0 + 32);
        SA_COMPUTE(key0);
    }
    if (ksp == 1) {
        for (int it = 0; it < 2; ++it) {
            const int key0 = 2048 + it * 32;
            bf16x8 kf[4]; bf16x8 vf[2][2];
            const bf16* kpu = Kb + (size_t)(MP + db * 64 + key0 - 2048) * 1024 + h * 128 + t * 64;
            const bf16* vpu = Vb + (size_t)(MP + db * 64 + key0 - 2048) * 1024 + h * 128;
#pragma unroll
            for (int d0 = 0; d0 < 4; ++d0) kf[d0] = *(const bf16x8*)(kpu + (klo + d0 * 16));
#pragma unroll
            for (int e = 0; e < 8; ++e) { const bf16* r0 = vpu + crow(e, 0) * 1024; const bf16* r1 = vpu + (16 + crow(e, 0)) * 1024;
#pragma unroll
                for (int d2 = 0; d2 < 2; ++d2) { vf[d2][0][e] = (short)r0[vlo + d2 * 32]; vf[d2][1][e] = (short)r1[vlo + d2 * 32]; } }
            SA_COMPUTE(key0);
        }
    }
#undef SA_LOAD
#undef SA_CVT
#undef SA_COMPUTE
    l += __shfl_xor(l, 32);
    LAS float* xo = (LAS float*)lds;
    LAS float* xm = (LAS float*)(lds + 4 * 2048 * 4);
    const int slot = wave & 3;
    __syncthreads();
    if (ksp == 1) {
#pragma unroll
        for (int i = 0; i < 2; ++i)
#pragma unroll
            for (int r = 0; r < 16; ++r) xo[(slot * 32 + i * 16 + r) * 64 + lane] = o[i][r];
        xm[(slot * 2 + 0) * 64 + lane] = m; xm[(slot * 2 + 1) * 64 + lane] = l; }
    __syncthreads();
    if (ksp == 0) {
        const float m1 = xm[(slot * 2 + 0) * 64 + lane], l1 = xm[(slot * 2 + 1) * 64 + lane];
        const float mn = fmaxf(m, m1), a0 = __builtin_amdgcn_exp2f(m - mn), a1 = __builtin_amdgcn_exp2f(m1 - mn);
        const float inv = 1.0f / (l * a0 + l1 * a1); const float f0 = a0 * inv, f1 = a1 * inv;
#pragma unroll
        for (int r = 0; r < 16; ++r) { const float g0 = __shfl(f0, crow(r, hi)), g1 = __shfl(f1, crow(r, hi));
            bf16* op = Ob + (size_t)(MP + db * 64 + qg * 32 + crow(r, hi)) * 2048 + h * 256 + t * 128 + dvh * 64 + r32;
#pragma unroll
            for (int i = 0; i < 2; ++i) op[i * 32] = (bf16)f2bf(o[i][r] * g0 + xo[(slot * 32 + i * 16 + r) * 64 + lane] * g1); } }
    __syncthreads();
}
__device__ __forceinline__ void combine_rows(const Args& a, float lam, int gw, int NGW, int lane) {
    const bf16* O = (const bf16*)(a.ws + WS_O); bf16* CAT = (bf16*)(a.ws + WS_CAT);
    const int h = lane >> 3, d0 = (lane & 7) * 16;
    float sg[16];
#pragma unroll
    for (int e = 0; e < 16; ++e) sg[e] = a.in[I_SUBG][d0 + e] * 0.8f;
    for (int row = gw; row < MROWS; row += NGW) {
        const v4u* p1 = (const v4u*)(O + (size_t)row * 2048 + h * 256 + d0); const v4u* p2 = (const v4u*)(O + (size_t)row * 2048 + h * 256 + 128 + d0);
        const v4u a0 = p1[0], a1 = p1[1], b0 = p2[0], b1 = p2[1];
        const unsigned aw[8] = {a0.x, a0.y, a0.z, a0.w, a1.x, a1.y, a1.z, a1.w}, bw[8] = {b0.x, b0.y, b0.z, b0.w, b1.x, b1.y, b1.z, b1.w};
        float d[16]; float q = 0.f;
#pragma unroll
        for (int e = 0; e < 8; ++e) { d[2 * e] = bflo(aw[e]) - lam * bflo(bw[e]); d[2 * e + 1] = bfhi(aw[e]) - lam * bfhi(bw[e]); q += d[2 * e] * d[2 * e] + d[2 * e + 1] * d[2 * e + 1]; }
        q += __shfl_xor(q, 1); q += __shfl_xor(q, 2); q += __shfl_xor(q, 4);
        const float rs = 1.0f / sqrtf(q * (1.0f / 128.0f) + EPS);
        v4u o0, o1;
        o0.x = pk2(d[0] * rs * sg[0], d[1] * rs * sg[1]); o0.y = pk2(d[2] * rs * sg[2], d[3] * rs * sg[3]); o0.z = pk2(d[4] * rs * sg[4], d[5] * rs * sg[5]); o0.w = pk2(d[6] * rs * sg[6], d[7] * rs * sg[7]);
        o1.x = pk2(d[8] * rs * sg[8], d[9] * rs * sg[9]); o1.y = pk2(d[10] * rs * sg[10], d[11] * rs * sg[11]); o1.z = pk2(d[12] * rs * sg[12], d[13] * rs * sg[13]); o1.w = pk2(d[14] * rs * sg[14], d[15] * rs * sg[15]);
        v4u* dst = (v4u*)(CAT + (size_t)row * 2048 + 1024 + h * 128 + d0); dst[0] = o0; dst[1] = o1;
    }
}

constexpr int NPH = 10;
__global__ void __launch_bounds__(NTHR, 2) fwd_megakernel(Args args) {
    extern __shared__ __attribute__((aligned(16))) unsigned char lds_raw[];
    LAS unsigned char* lds = (LAS unsigned char*)lds_raw;
    const int wave = __builtin_amdgcn_readfirstlane((int)threadIdx.x >> 6);
#define FRESH() const int lane = fresh_lane(); const int tid = wave * 64 + lane; (void)tid
    const int G = gridDim.x, bx = blockIdx.x; const int vcu = (G % 8 == 0) ? (bx % 8) * (G / 8) + bx / 8 : bx;
    const int gw = vcu * NWAVES + wave, NGW = G * NWAVES;
    cg::grid_group grid = cg::this_grid();
    const int lo = args.ph_lo, hi = args.ph_hi; int nbar = 0;
#ifndef PH_ONLY
#define PH_ONLY -1
#endif
#define IN(k) ((PH_ONLY < 0 || PH_ONLY == (k)) && lo <= (k) && (k) < hi)
#define REPS(k) _Pragma("nounroll") for (int rep_ = 0, nrep_ = opaque_i(((PROBE_REP >> (k)) & 1) ? 2 : 1); rep_ < nrep_; ++rep_)
#define SEAM(k) do { if (IN(k) && IN((k) + 1)) { if ((k) == 0) grid.sync(); else { ++nbar; \
        asm volatile("s_waitcnt vmcnt(0) lgkmcnt(0)" ::: "memory"); __syncthreads(); \
        if (wave == 0) { if (fresh_lane() == 0) { unsigned* ctr = (unsigned*)(args.ws + WS_BAR); \
            __builtin_amdgcn_fence(__ATOMIC_RELEASE, "agent"); asm volatile("s_waitcnt vmcnt(0)" ::: "memory"); \
            __hip_atomic_fetch_add(ctr, 1u, __ATOMIC_RELAXED, __HIP_MEMORY_SCOPE_AGENT); \
            const unsigned want = (unsigned)G * (unsigned)nbar; \
            while (__hip_atomic_load(ctr, __ATOMIC_RELAXED, __HIP_MEMORY_SCOPE_AGENT) < want) __builtin_amdgcn_s_sleep(2); \
            __builtin_amdgcn_fence(__ATOMIC_ACQUIRE, "agent"); asm volatile("s_waitcnt vmcnt(0)" ::: "memory"); } } \
        __syncthreads(); } } } while (0)
    unsigned char* ws = args.ws;
    const float* mod = (const float*)(ws + WS_MOD); const float* modf = (const float*)(ws + WS_MODF);
    bf16* Hb = (bf16*)(ws + WS_H);

    if (IN(0)) REPS(0) { FRESH(); p0_prologue(args, lds, vcu, G, tid, wave, lane); }
    SEAM(0);
    if (IN(1)) REPS(1) { FRESH(); norm_mod_rows<false>(args.in[I_XP], args.in[I_XS], nullptr, nullptr, args.in[I_GMIX], mod + 0, mod + 2048, 12288, Hb, gw, NGW, lane); }
    SEAM(1);
    if (IN(2)) {
        pg8::Gemm g{Hb, (const bf16*)(ws + WS_WIN), MROWS, NIN, D}; pg8::StaticOrder S; S.init(MROWS, NIN, D, G, bx, ((PROBE_REP >> 2) & 1) + 1);
        pg8::EpiIn E{(bf16*)(ws + WS_U), (bf16*)(ws + WS_G), (bf16*)(ws + WS_Q), (bf16*)(ws + WS_K), (bf16*)(ws + WS_V), args.out};
        pg8::gemm_phase<pg8::EpiIn, pg8::StaticOrder, true, true>(lds, g, S, E, wave);
    }
    SEAM(2);
    if (IN(3)) {
        LAS float* bt = (LAS float*)(lds + BT_OFF);
        __syncthreads();
        { FRESH(); bias_table(args, bt, tid); }
        __syncthreads();
        REPS(10) for (int v = vcu; v < 256; v += G) {
#ifndef NO_SMALL
            { FRESH(); sattn_unit(args, lds, bt, v >> 4, (v >> 1) & 7, v & 1, tid, wave, lane); }
            { FRESH(); sgate_unit(args, lds, v, tid, wave, lane); } if (v >= 240) { FRESH(); sgate_unit(args, lds, 256 + (v - 240), tid, wave, lane); }
#endif
        }
        __syncthreads();
        REPS(11) for (int v = vcu; v < 256; v += G) {
            const int combo = v >> 3, j = v & 7; const int b = combo >> 4, hh = combo & 15;
#pragma nounroll
            for (int i = 0; i < 8; ++i) { const int x = 8 * (i >> 1) + j; int qb = (i & 1) ? 63 - x : x; int b_ = b, hh_ = hh; asm volatile("" : "+s"(qb), "+s"(b_), "+s"(hh_));
#ifndef NO_ATTN
                attn_body::attn_unit<8>(b_, hh_, qb, (const attn_body::bf16*)(ws + WS_Q), (const attn_body::bf16*)(ws + WS_K), (const attn_body::bf16*)(ws + WS_V), (attn_body::bf16*)(ws + WS_O), (char*)lds_raw, (attn_body::lds_cfptr)(bt + (hh_ >> 1) * 196), wave);
#endif
            }
        }
    }
    SEAM(3);
    if (IN(4)) REPS(4) { FRESH(); const float lam = diff_lambda(args, lane); combine_rows(args, lam, gw, NGW, lane); }
    SEAM(4);
    if (IN(5)) {
        pg8::Gemm g{(const bf16*)(ws + WS_CAT), (const bf16*)(ws + WS_WOUT), MROWS, D, D}; pg8::StaticOrder S; S.init(MROWS, D, D, G, bx, 1, 4);
        pg8::EpiRes E{args.in[I_XP], nullptr, (bf16*)(ws + WS_X1B), mod + 4096, (float*)(ws + WS_PART)};
        pg8::gemm_phase<pg8::EpiRes, pg8::StaticOrder, true, true>(lds, g, S, E, wave);
    }
    SEAM(5);
    if (IN(6)) REPS(6) { FRESH(); norm_mod_rows<false>(nullptr, args.in[I_XS], (const bf16*)(ws + WS_X1B), nullptr, args.in[I_GFFN], mod + 6144, mod + 8192, 12288, Hb, gw, NGW, lane, (const float*)(ws + WS_PART), (bf16*)(ws + WS_X1B)); }
    SEAM(6);
    if (IN(7)) {
        pg8::Gemm g{Hb, (const bf16*)(ws + WS_WFI), MROWS, 2 * DFF, D}; pg8::StaticOrder S; S.init(MROWS, 2 * DFF, D, G, bx, ((PROBE_REP >> 7) & 1) + 1);
        pg8::EpiGlu E{(bf16*)(ws + WS_F)};
        pg8::gemm_phase<pg8::EpiGlu, pg8::StaticOrder, true, true>(lds, g, S, E, wave);
    }
    SEAM(7);
    if (IN(8)) {
        pg8::Gemm g{(const bf16*)(ws + WS_F), (const bf16*)(ws + WS_WFO), MROWS, D, DFF}; pg8::StaticOrder S; S.init(MROWS, D, DFF, G, bx, 1, 4);
        pg8::EpiRes E{nullptr, (const bf16*)(ws + WS_X1B), (bf16*)(ws + WS_X2B), mod + 10240, (float*)(ws + WS_PART)};
        pg8::gemm_phase<pg8::EpiRes, pg8::StaticOrder, true, true>(lds, g, S, E, wave);
    }
    SEAM(8);
    if (IN(9)) { FRESH(); norm_mod_rows<true>(nullptr, nullptr, (const bf16*)(ws + WS_X2B), (const bf16*)(ws + WS_X1B), args.in[I_GFIN], modf + 0, modf + 2048, 4096, args.out + OUT_Y, gw, NGW, lane, (const float*)(ws + WS_PART), nullptr); }
#undef IN
#undef SEAM
}

#ifndef MK_ONE_LAUNCH
#define MK_ONE_LAUNCH 1
#endif
extern "C" void kernel_launch(void* const* d_in, const int* in_sizes, int n_in, void* d_out, int out_size, void* d_ws, size_t ws_size, hipStream_t stream) {
    static int grid = 0;
    if (grid == 0) {
        if (n_in != 27 || ws_size < WS_END) { fprintf(stderr, "kernel_launch: unexpected inputs (n_in %d, ws %zu)\n", n_in, ws_size); grid = -1; return; }
        int dev = 0, cus = 0, per_cu = 0;
        hipGetDevice(&dev); hipDeviceGetAttribute(&cus, hipDeviceAttributeMultiprocessorCount, dev);
        if (hipFuncSetAttribute((const void*)fwd_megakernel, hipFuncAttributeMaxDynamicSharedMemorySize, LDS_BYTES) != hipSuccess) { fprintf(stderr, "kernel_launch: hipFuncSetAttribute failed\n"); grid = -1; return; }
        if (hipOccupancyMaxActiveBlocksPerMultiprocessor(&per_cu, (const void*)fwd_megakernel, NTHR, LDS_BYTES) != hipSuccess || per_cu < 1) per_cu = 1;
        (void)hipGetLastError();
        grid = cus * per_cu; if (grid <= 0) grid = 256;
    }
    if (grid < 0) return;
    Args a{};
    for (int i = 0; i < 27; ++i) a.in[i] = (const float*)d_in[i];
    a.out = (float*)d_out; a.ws = (unsigned char*)d_ws;
#if MK_ONE_LAUNCH
    a.ph_lo = 0; a.ph_hi = NPH;
    (void)hipMemsetAsync((unsigned char*)d_ws + WS_BAR, 0, 256, stream);
    void* kargs[] = {&a};
    hipError_t e = hipLaunchCooperativeKernel((const void*)fwd_megakernel, dim3(grid), dim3(NTHR), kargs, LDS_BYTES, stream);
    if (e != hipSuccess) fprintf(stderr, "cooperative launch failed: %s (grid %d)\n", hipGetErrorString(e), grid);
#else
    for (int p = 0; p < NPH; ++p) { a.ph_lo = p; a.ph_hi = p + 1; hipLaunchKernelGGL(fwd_megakernel, dim3(grid), dim3(NTHR), LDS_BYTES, stream, a); }
#endif
}
```
